# Optimizing an MI355X kernel written in HIP

```python
import jax, jax.numpy as jnp
from jax import lax
import numpy as np

D_MODEL = 1024
BATCH = 8
SEQ = 2048
DEPTH = 1

GRID_W = 64
CTX_LEN = 256
N_HEADS = 8
QK_NOPE_DIM = 64
QK_ROPE_DIM = 32
V_HEAD_DIM = 64
Q_LORA_RANK = 384
KV_LORA_RANK = 256
ROPE_THETA = 10000.0
CONV_DIM = 512
CONV_WIDTH = 3
D_FF = 2816
Q_BLOCK = 128
EPS = 1e-6
ATTN_DIM = N_HEADS * V_HEAD_DIM
KV_END = KV_LORA_RANK
KR_END = KV_END + QK_ROPE_DIM
Q_END = KR_END + Q_LORA_RANK
CX_END = Q_END + CONV_DIM
CB_END = CX_END + CONV_DIM
CC_END = CB_END + CONV_DIM
GA_END = CC_END + D_MODEL
GC_END = GA_END + D_MODEL
IN_COLS = GC_END

kernel_name = 'hybrid_mla_shortconv_convffn_dit_block'


def rmsnorm(x, g):
    xf = x.astype(jnp.float32)
    y = xf * lax.rsqrt(jnp.mean(xf * xf, axis=-1, keepdims=True) + EPS)
    return (y * g.astype(jnp.float32)).astype(x.dtype)


def modulate(h, shift, scale):
    return h * (1 + scale[:, None, :]) + shift[:, None, :]


def dwconv(x, w, b):
    T = x.shape[1]
    pad = CONV_WIDTH // 2
    xp = jnp.pad(x, ((0, 0), (pad, CONV_WIDTH - 1 - pad), (0, 0)))
    y = b
    for k in range(CONV_WIDTH):
        y = y + xp[:, k:k + T] * w[k]
    return y


def axial_angles(rows):
    row = jnp.repeat(jnp.arange(rows), GRID_W).astype(jnp.float32)
    col = jnp.tile(jnp.arange(GRID_W), rows).astype(jnp.float32)
    axis_dim = QK_ROPE_DIM // 2
    inv = ROPE_THETA ** (-jnp.arange(0, axis_dim, 2, dtype=jnp.float32) / axis_dim)
    return jnp.concatenate([row[:, None] * inv, col[:, None] * inv], axis=-1)


def rope2d(x, ang):
    nf = QK_ROPE_DIM // 4
    xr = x.reshape(*x.shape[:-1], 2, 2, nf)
    x1, x2 = xr[..., 0, :], xr[..., 1, :]
    a = ang.reshape(ang.shape[0], 1, 2, nf)
    cos, sin = jnp.cos(a).astype(x.dtype), jnp.sin(a).astype(x.dtype)
    out = jnp.stack([x1 * cos - x2 * sin, x1 * sin + x2 * cos], axis=-2)
    return out.reshape(x.shape)


def mla_kv(p, kv_norm_g, w_ukv, ang):
    B, T = p.shape[:2]
    ckv = rmsnorm(p[..., :KV_END], kv_norm_g)
    kv = (ckv @ w_ukv).reshape(B, T, N_HEADS, QK_NOPE_DIM + V_HEAD_DIM)
    k_nope, v = kv[..., :QK_NOPE_DIM], kv[..., QK_NOPE_DIM:]
    k_rope = p[..., KV_END:KR_END][:, :, None, :]
    if ang is not None:
        k_rope = rope2d(k_rope, ang)
    return k_nope, k_rope[:, :, 0], v


def mla_query(p, q_norm_g, w_uq, ang):
    B, T = p.shape[:2]
    cq = rmsnorm(p[..., KR_END:Q_END], q_norm_g)
    q = (cq @ w_uq).reshape(B, T, N_HEADS, QK_NOPE_DIM + QK_ROPE_DIM)
    q_nope, q_rope = q[..., :QK_NOPE_DIM], q[..., QK_NOPE_DIM:]
    if ang is not None:
        q_rope = rope2d(q_rope, ang)
    return q_nope, q_rope


def mla_attend(q_nope, q_rope, k_nope, k_rope, v):
    scale = (QK_NOPE_DIM + QK_ROPE_DIM) ** -0.5
    s = (jnp.einsum('bqhd,bkhd->bhqk', q_nope, k_nope)
         + jnp.einsum('bqhr,bkr->bhqk', q_rope, k_rope))
    pr = jax.nn.softmax(s.astype(jnp.float32) * scale, axis=-1).astype(v.dtype)
    return jnp.einsum('bhqk,bkhd->bqhd', pr, v)


def mla_latent(q_nope, q_rope, k_nope, k_rope, v):
    B, T = q_nope.shape[:2]
    nb = T // Q_BLOCK

    def blocks(a):
        return a.reshape(B, nb, Q_BLOCK, *a.shape[2:]).swapaxes(0, 1)

    o = lax.map(lambda qs: mla_attend(qs[0], qs[1], k_nope, k_rope, v), (blocks(q_nope), blocks(q_rope)))
    return o.swapaxes(0, 1).reshape(B, T, ATTN_DIM)


def gated_merge(p, o_attn, conv_w, conv_b, w_attn_out, w_conv_out, w_o):
    x_in = p[..., Q_END:CX_END]
    b_gate = p[..., CX_END:CB_END]
    c_gate = p[..., CB_END:CC_END]
    y_conv = (b_gate * dwconv(c_gate * x_in, conv_w, conv_b)) @ w_conv_out
    y_attn = o_attn @ w_attn_out
    g_attn = jax.nn.sigmoid(p[..., CC_END:GA_END])
    g_conv = jax.nn.sigmoid(p[..., GA_END:GC_END])
    return (g_attn * y_attn + g_conv * y_conv) @ w_o


def conv_ffn(h, w_up, conv_w, conv_b, w_down):
    u = dwconv(h @ w_up, conv_w, conv_b)
    gate, val = jnp.split(u, 2, axis=-1)
    return (jax.nn.silu(gate) * val) @ w_down


def trunk_layer(x, ctx, mod_lat, mod_ctx, ang, update_ctx, norm1_g, w_in, q_norm_g, kv_norm_g,
                w_uq, w_ukv, conv_w, conv_b, w_attn_out, w_conv_out, w_o, norm2_g, w_up,
                ffn_conv_w, ffn_conv_b, w_down):
    sh1, sc1, g1, sh2, sc2, g2 = jnp.split(mod_lat, 6, axis=-1)
    csh1, csc1, cg1, csh2, csc2, cg2 = jnp.split(mod_ctx, 6, axis=-1)
    h = modulate(rmsnorm(x, norm1_g), sh1, sc1)
    hc = modulate(rmsnorm(ctx, norm1_g), csh1, csc1)
    p = h @ w_in
    pc = hc @ w_in if update_ctx else hc @ w_in[:, :KR_END]
    kn_c, kr_c, v_c = mla_kv(pc, kv_norm_g, w_ukv, None)
    kn_l, kr_l, v_l = mla_kv(p, kv_norm_g, w_ukv, ang)
    qn, qr = mla_query(p, q_norm_g, w_uq, ang)
    o = mla_latent(qn, qr, jnp.concatenate([kn_c, kn_l], axis=1),
                   jnp.concatenate([kr_c, kr_l], axis=1), jnp.concatenate([v_c, v_l], axis=1))
    x = x + g1[:, None, :] * gated_merge(p, o, conv_w, conv_b, w_attn_out, w_conv_out, w_o)
    x = x + g2[:, None, :] * conv_ffn(modulate(rmsnorm(x, norm2_g), sh2, sc2), w_up, ffn_conv_w, ffn_conv_b, w_down)
    if update_ctx:
        qn_c, qr_c = mla_query(pc, q_norm_g, w_uq, None)
        oc = mla_attend(qn_c, qr_c, kn_c, kr_c, v_c).reshape(ctx.shape[0], ctx.shape[1], ATTN_DIM)
        ctx = ctx + cg1[:, None, :] * gated_merge(pc, oc, conv_w, conv_b, w_attn_out, w_conv_out, w_o)
        ctx = ctx + cg2[:, None, :] * conv_ffn(modulate(rmsnorm(ctx, norm2_g), csh2, csc2), w_up, ffn_conv_w, ffn_conv_b, w_down)
    return x, ctx


def setup_inputs(seed: int = 0) -> dict:
    key = jax.random.key(seed)
    ks = jax.random.split(key, 24)
    L, D = DEPTH, D_MODEL

    def nrm(k, shape, fan_in, gain=1.0):
        return jax.random.normal(k, shape, jnp.float32) * (gain * fan_in ** -0.5)

    def norm_gain(k, shape):
        return 1.0 + 0.05 * jax.random.normal(k, shape, jnp.float32)

    def bias(k, shape):
        return 0.02 * jax.random.normal(k, shape, jnp.float32)

    return {
        'x': jax.random.normal(ks[0], (BATCH, SEQ, D), jnp.float32),
        'c': jax.random.normal(ks[1], (BATCH, D), jnp.float32),
        'ctx': jax.random.normal(ks[2], (BATCH, CTX_LEN, D), jnp.float32),
        'c_ctx': jax.random.normal(ks[3], (D,), jnp.float32),
        'w_ada': nrm(ks[4], (L, D, 6 * D), D, 0.5),
        'b_ada': bias(ks[5], (L, 6 * D)),
        'norm1_g': norm_gain(ks[6], (L, D)),
        'w_in': nrm(ks[7], (L, D, IN_COLS), D),
        'q_norm_g': norm_gain(ks[8], (L, Q_LORA_RANK)),
        'kv_norm_g': norm_gain(ks[9], (L, KV_LORA_RANK)),
        'w_uq': nrm(ks[10], (L, Q_LORA_RANK, N_HEADS * (QK_NOPE_DIM + QK_ROPE_DIM)), Q_LORA_RANK),
        'w_ukv': nrm(ks[11], (L, KV_LORA_RANK, N_HEADS * (QK_NOPE_DIM + V_HEAD_DIM)), KV_LORA_RANK),
        'conv_w': nrm(ks[12], (L, CONV_WIDTH, CONV_DIM), CONV_WIDTH),
        'conv_b': bias(ks[13], (L, CONV_DIM)),
        'w_attn_out': nrm(ks[14], (L, ATTN_DIM, D), ATTN_DIM),
        'w_conv_out': nrm(ks[15], (L, CONV_DIM, D), CONV_DIM),
        'w_o': nrm(ks[16], (L, D, D), D),
        'norm2_g': norm_gain(ks[17], (L, D)),
        'w_up': nrm(ks[18], (L, D, 2 * D_FF), D),
        'ffn_conv_w': nrm(ks[19], (L, CONV_WIDTH, 2 * D_FF), CONV_WIDTH),
        'ffn_conv_b': bias(ks[20], (L, 2 * D_FF)),
        'w_down': nrm(ks[21], (L, D_FF, D), D_FF),
        'final_g': norm_gain(ks[22], (D,)),
    }


def reference(x, c, ctx, c_ctx, w_ada, b_ada, norm1_g, w_in, q_norm_g, kv_norm_g, w_uq, w_ukv,
              conv_w, conv_b, w_attn_out, w_conv_out, w_o, norm2_g, w_up, ffn_conv_w, ffn_conv_b,
              w_down, final_g):
    rows = x.shape[1] // GRID_W
    ang = axial_angles(rows)
    sc = jax.nn.silu(c)
    sc_ctx = jax.nn.silu(c_ctx)[None, :]
    for i in range(DEPTH):
        mod_lat = sc @ w_ada[i] + b_ada[i]
        mod_ctx = sc_ctx @ w_ada[i] + b_ada[i]
        x, ctx = trunk_layer(x, ctx, mod_lat, mod_ctx, ang, i < DEPTH - 1, norm1_g[i], w_in[i],
                             q_norm_g[i], kv_norm_g[i], w_uq[i], w_ukv[i], conv_w[i], conv_b[i],
                             w_attn_out[i], w_conv_out[i], w_o[i], norm2_g[i], w_up[i],
                             ffn_conv_w[i], ffn_conv_b[i], w_down[i])
    return rmsnorm(x, final_g)
```

```cpp
#include <hip/hip_runtime.h>
#include <cstdio>
#include <cstdint>

#define LAS __attribute__((address_space(3)))
#define GAS __attribute__((address_space(1)))
typedef unsigned short bf16;
typedef unsigned v4u __attribute__((ext_vector_type(4)));
typedef unsigned v2u __attribute__((ext_vector_type(2)));
typedef float f32x4 __attribute__((ext_vector_type(4)));
typedef float f32x2 __attribute__((ext_vector_type(2)));
typedef short bf16x8 __attribute__((ext_vector_type(8)));

constexpr int NB = 8, T = 2048, D = 1024, CTXL = 256, NH = 8, DN = 64, DR = 32, DQK = 96, DV = 64, QL = 384, KVL = 256, CD = 512, FF = 2816;
constexpr int TK = CTXL + T;
constexpr int M = NB * T;
constexpr int MC = NB * CTXL;
constexpr int MKV = M + MC;
constexpr int NIN = 4352;
constexpr int NUP = 2 * FF;
constexpr float EPS = 1e-6f;
constexpr float QSCALE = 0.10206207261596575f * 1.4426950408889634f;
constexpr int MODW = 6 * D;

constexpr size_t MiB = 1u << 20;
constexpr size_t WS_CTL = 0, CTL_ZERO_BYTES = 1 * MiB;
constexpr size_t WS_MOD = 1 * MiB;
constexpr size_t WS_ROPE = 1 * MiB + 256 * 1024;
constexpr size_t WS_SHW = 1 * MiB + 512 * 1024;
constexpr size_t WS_FCW = 1 * MiB + 768 * 1024;
constexpr size_t WS_FCB = 1 * MiB + 896 * 1024;
constexpr size_t WS_SSQKV = 2 * MiB;
constexpr size_t WS_SSQQ = 2 * MiB + 512 * 1024;
constexpr size_t WS_SSQ2 = 3 * MiB;
constexpr size_t WS_SSQ3 = 4 * MiB;
constexpr size_t WS_WIN = 8 * MiB;
constexpr size_t WS_WUQ = 17 * MiB;
constexpr size_t WS_WUKV = 18 * MiB;
constexpr size_t WS_WCAT = 19 * MiB;
constexpr size_t WS_WO = 21 * MiB;
constexpr size_t WS_WUP = 23 * MiB;
constexpr size_t WS_WDOWN = 34 * MiB;
constexpr size_t WS_KVLAT = 40 * MiB;
constexpr size_t WS_QLAT = 49 * MiB;
constexpr size_t WS_S = 61 * MiB;
constexpr size_t WS_BG = 77 * MiB;
constexpr size_t WS_RAT = 93 * MiB;
constexpr size_t WS_GC = 125 * MiB;
constexpr size_t WS_KB = 157 * MiB;
constexpr size_t WS_ACAT = 184 * MiB;
constexpr size_t WS_MERGED = 216 * MiB;
constexpr size_t WS_A2 = 93 * MiB;
constexpr size_t WS_ACT = 125 * MiB;
constexpr size_t WS_HALO = 216 * MiB;
constexpr size_t WS_END = 256 * MiB;
constexpr size_t DO_H = 0;
constexpr size_t DO_QB = 0;
constexpr size_t DO_VB = 24 * MiB;

__device__ __forceinline__ float bf2f(unsigned v) { return __uint_as_float(v << 16); }
__host__ __device__ __forceinline__ unsigned f2bf(float f) { unsigned u = __builtin_bit_cast(unsigned, f); return (u + 0x7fffu + ((u >> 16) & 1u)) >> 16; }
__device__ __forceinline__ unsigned pk2(float lo, float hi) { return f2bf(lo) | (f2bf(hi) << 16); }
__device__ __forceinline__ float silu_f(float x) { return x / (1.f + __expf(-x)); }
__device__ __forceinline__ float sigm_f(float x) { return 1.f / (1.f + __expf(-x)); }
__device__ __forceinline__ float wave_sum(float v) {
#pragma unroll
    for (int o = 1; o < 64; o <<= 1) v += __shfl_xor(v, o);
    return v;
}
__host__ __device__ __forceinline__ int rope_orig(int j) { const int p = j & 1, kf = j >> 1, a = kf >> 3, f = kf & 7; return a * 16 + p * 8 + f; }
__host__ __device__ __forceinline__ int win_map(int n) {
    const int pn = n >> 8, r = n & 255;
    if (pn == 0) return r;
    if (pn == 1) return 288 + r;
    if (pn == 2) { if (r < 128) return 544 + r; if (r < 160) return 256 + rope_orig(r - 128); return -1; }
    if (pn < 7) { const int j = pn - 3; return r < 128 ? 672 + 128 * j + r : 1696 + 128 * j + (r - 128); }
    if (pn < 9) return 1184 + (n - 7 * 256);
    { const int j = pn - 9; return r < 128 ? 2208 + 128 * j + r : 3232 + 128 * j + (r - 128); }
}
__host__ __device__ __forceinline__ int wuq_map(int n) { const int h = n / 96, d = n % 96; return d < 64 ? n : h * 96 + 64 + rope_orig(d - 64); }
__host__ __device__ __forceinline__ int wup_map(int n) { const int pn = n >> 8, r = n & 255; return r < 128 ? 128 * pn + r : FF + 128 * pn + (r - 128); }
__host__ __device__ __forceinline__ int ident_map(int n) { return n; }
struct WinMap { __device__ __forceinline__ int operator()(int n) const { return win_map(n); } };
struct WuqMap { __device__ __forceinline__ int operator()(int n) const { return wuq_map(n); } };
struct WupMap { __device__ __forceinline__ int operator()(int n) const { return wup_map(n); } };
struct IdMap { __device__ __forceinline__ int operator()(int n) const { return n; } };
__device__ __forceinline__ void kv_row(int row, int& b, int& tk) { if (row < M) { b = row >> 11; tk = CTXL + (row & 2047); } else { const int r = row - M; b = r >> 8; tk = r & 255; } }

struct Args { const float* in[23]; float* out; unsigned char* ws; int ph_lo, ph_hi; };
enum { I_X = 0, I_C, I_CTX, I_CCTX, I_WADA, I_BADA, I_N1G, I_WIN, I_QNG, I_KVNG, I_WUQ, I_WUKV, I_CW, I_CB, I_WAO, I_WCO, I_WO, I_N2G, I_WUP, I_FCW, I_FCB, I_WDOWN, I_FG };

constexpr int NWAVES = 8;
constexpr int LDS_BYTES = 147456;

template <class Map>
__device__ __forceinline__ void tr_item(const float* W, int Ns, bf16* WT, int ld, int dk0, const float* kscale, Map map, int nblk, LAS float* scr, int item, int lane) {
    const int kb = item / nblk, nb = item % nblk, k0 = 64 * kb, n0 = 32 * nb;
    const int src = map(n0 + (lane & 31));
#pragma unroll 8
    for (int i = 0; i < 32; ++i) { const int kk = 2 * i + (lane >> 5); float v = 0.f; if (src >= 0) { v = W[(size_t)(k0 + kk) * Ns + src]; if (kscale) v *= kscale[k0 + kk]; } scr[kk * 33 + (lane & 31)] = v; }
    asm volatile("s_waitcnt lgkmcnt(0)" ::: "memory");
    const int c = lane & 7;
#pragma unroll
    for (int j = 0; j < 4; ++j) { const int n = (lane >> 3) + 8 * j; const LAS float* s = scr + (8 * c) * 33 + n;
        v4u o; o.x = pk2(s[0 * 33], s[1 * 33]); o.y = pk2(s[2 * 33], s[3 * 33]); o.z = pk2(s[4 * 33], s[5 * 33]); o.w = pk2(s[6 * 33], s[7 * 33]);
        *(v4u*)(WT + (size_t)(n0 + n) * ld + dk0 + k0 + 8 * c) = o; }
    asm volatile("s_waitcnt lgkmcnt(0)" ::: "memory");
}

__device__ __forceinline__ void p0_body(const Args& a, LAS unsigned char* lds, int tid, int lane, int wave, int vcu, int G) {
    unsigned char* ws = a.ws;
    {
        LAS float* sc = (LAS float*)lds;
        LAS float* red = (LAS float*)(lds + 9 * 1024 * 4);
        float* MOD = (float*)(ws + WS_MOD);
        bool loaded = false;
        for (int u = vcu; u < MODW / 32; u += G) {
            if (!loaded) {
                for (int i = tid; i < 9 * 1024; i += NWAVES * 64) { const int b = i >> 10, k = i & 1023; const float v = b < 8 ? a.in[I_C][b * 1024 + k] : a.in[I_CCTX][k]; sc[i] = silu_f(v); }
                loaded = true;
            }
            __syncthreads();
            const int col = tid & 31, kg = tid >> 5;
            float acc[9];
#pragma unroll
            for (int b = 0; b < 9; ++b) acc[b] = 0.f;
            const float* wp = a.in[I_WADA] + (size_t)u * 32 + col;
#pragma unroll 4
            for (int k = kg; k < 1024; k += 16) { const float w = wp[(size_t)k * MODW];
#pragma unroll
                for (int b = 0; b < 9; ++b) acc[b] += sc[b * 1024 + k] * w; }
#pragma unroll
            for (int b = 0; b < 9; ++b) red[(kg * 9 + b) * 32 + col] = acc[b];
            __syncthreads();
            if (tid < 9 * 32) { const int b = tid >> 5, c2 = tid & 31; float s = 0.f;
#pragma unroll
                for (int g = 0; g < 16; ++g) s += red[(g * 9 + b) * 32 + c2];
                MOD[b * MODW + u * 32 + c2] = s + a.in[I_BADA][u * 32 + c2]; }
            __syncthreads();
        }
        __syncthreads();
    }
    {
        LAS float* scr = (LAS float*)(lds + wave * 16384);
        const int gw = vcu * NWAVES + wave, NGW = G * NWAVES;
        constexpr int I_IN = 16 * (NIN / 32), I_UQ = 6 * 24, I_UKV = 4 * 32, I_AO = 8 * 32, I_CO = 8 * 32, I_O = 16 * 32, I_UP = 16 * (NUP / 32), I_DN = 44 * 32;
        constexpr int NITEMS = I_IN + I_UQ + I_UKV + I_AO + I_CO + I_O + I_UP + I_DN;
        for (int it = gw; it < NITEMS; it += NGW) {
            int r = it;
            if (r < I_IN) { tr_item(a.in[I_WIN], 4256, (bf16*)(ws + WS_WIN), 1024, 0, nullptr, WinMap(), NIN / 32, scr, r, lane); continue; } r -= I_IN;
            if (r < I_UQ) { tr_item(a.in[I_WUQ], 768, (bf16*)(ws + WS_WUQ), 384, 0, a.in[I_QNG], WuqMap(), 24, scr, r, lane); continue; } r -= I_UQ;
            if (r < I_UKV) { tr_item(a.in[I_WUKV], 1024, (bf16*)(ws + WS_WUKV), 256, 0, a.in[I_KVNG], IdMap(), 32, scr, r, lane); continue; } r -= I_UKV;
            if (r < I_AO) { tr_item(a.in[I_WAO], 1024, (bf16*)(ws + WS_WCAT), 1024, 0, nullptr, IdMap(), 32, scr, r, lane); continue; } r -= I_AO;
            if (r < I_CO) { tr_item(a.in[I_WCO], 1024, (bf16*)(ws + WS_WCAT), 1024, 512, nullptr, IdMap(), 32, scr, r, lane); continue; } r -= I_CO;
            if (r < I_O) { tr_item(a.in[I_WO], 1024, (bf16*)(ws + WS_WO), 1024, 0, nullptr, IdMap(), 32, scr, r, lane); continue; } r -= I_O;
            if (r < I_UP) { tr_item(a.in[I_WUP], NUP, (bf16*)(ws + WS_WUP), 1024, 0, nullptr, WupMap(), NUP / 32, scr, r, lane); continue; } r -= I_UP;
            tr_item(a.in[I_WDOWN], 1024, (bf16*)(ws + WS_WDOWN), FF, 0, nullptr, IdMap(), 32, scr, r, lane);
        }
    }
    {
        const int gt = vcu * NWAVES * 64 + tid, NGT = G * NWAVES * 64;
        float* ROPE = (float*)(ws + WS_ROPE);
        for (int i = gt; i < T * 16; i += NGT) { const int t = i >> 4, k = i & 15, ax = k >> 3, f = k & 7;
            const float inv = powf(10000.f, -(float)(2 * f) / 16.f); const float pos = (float)(ax == 0 ? (t >> 6) : (t & 63)); const float ang = pos * inv;
            ROPE[2 * i] = cosf(ang); ROPE[2 * i + 1] = sinf(ang); }
        float* FCW = (float*)(ws + WS_FCW); float* FCB = (float*)(ws + WS_FCB);
        for (int i = gt; i < 3 * NUP; i += NGT) { const int k = i / NUP, n = i % NUP; FCW[i] = a.in[I_FCW][k * NUP + wup_map(n)]; }
        for (int i = gt; i < NUP; i += NGT) FCB[i] = a.in[I_FCB][wup_map(i)];
    }
}

__device__ __forceinline__ void p1_body(const Args& a, int lane, int wave, int vcu, int G) {
    unsigned char* ws = a.ws;
    const float* MOD = (const float*)(ws + WS_MOD);
    bf16* Hb = (bf16*)((unsigned char*)a.out + DO_H);
    const int gw = vcu * NWAVES + wave, NGW = G * NWAVES;
    for (int row = gw; row < MKV; row += NGW) {
        const float* xr; int mb;
        if (row < M) { xr = a.in[I_X] + (size_t)row * D; mb = row >> 11; } else { xr = a.in[I_CTX] + (size_t)(row - M) * D; mb = 8; }
        const f32x4* x4 = (const f32x4*)xr + lane;
        f32x4 v[4]; float s = 0.f;
#pragma unroll
        for (int j = 0; j < 4; ++j) { v[j] = x4[64 * j]; s += (v[j].x * v[j].x + v[j].y * v[j].y) + (v[j].z * v[j].z + v[j].w * v[j].w); }
        const float rstd = 1.f / sqrtf(wave_sum(s) * (1.f / D) + EPS);
        const f32x4* g4 = (const f32x4*)a.in[I_N1G] + lane;
        const f32x4* sh4 = (const f32x4*)(MOD + mb * MODW) + lane;
        const f32x4* sc4 = (const f32x4*)(MOD + mb * MODW + D) + lane;
        unsigned long long* o8 = (unsigned long long*)(Hb + (size_t)row * D) + lane;
#pragma unroll
        for (int j = 0; j < 4; ++j) { const f32x4 g = g4[64 * j], sh = sh4[64 * j], sc = sc4[64 * j];
            const f32x4 y = (v[j] * rstd) * g * (sc + 1.f) + sh;
            o8[64 * j] = (unsigned long long)pk2(y.x, y.y) | ((unsigned long long)pk2(y.z, y.w) << 32); }
    }
    const bf16* WUP = (const bf16*)(ws + WS_WUP); float* SHW = (float*)(ws + WS_SHW);
    for (int n = gw; n < NUP; n += NGW) {
        const v4u* w4 = (const v4u*)(WUP + (size_t)n * D) + 2 * lane;
        const v4u w0 = w4[0], w1 = w4[1];
        float wf[16];
        wf[0] = bf2f(w0.x & 0xffff); wf[1] = bf2f(w0.x >> 16); wf[2] = bf2f(w0.y & 0xffff); wf[3] = bf2f(w0.y >> 16); wf[4] = bf2f(w0.z & 0xffff); wf[5] = bf2f(w0.z >> 16); wf[6] = bf2f(w0.w & 0xffff); wf[7] = bf2f(w0.w >> 16);
        wf[8] = bf2f(w1.x & 0xffff); wf[9] = bf2f(w1.x >> 16); wf[10] = bf2f(w1.y & 0xffff); wf[11] = bf2f(w1.y >> 16); wf[12] = bf2f(w1.z & 0xffff); wf[13] = bf2f(w1.z >> 16); wf[14] = bf2f(w1.w & 0xffff); wf[15] = bf2f(w1.w >> 16);
#pragma unroll
        for (int b = 0; b < 8; ++b) { const f32x4* s4 = (const f32x4*)(MOD + b * MODW + 3 * D) + 4 * lane; float s = 0.f;
#pragma unroll
            for (int q = 0; q < 4; ++q) { const f32x4 sv = s4[q]; s += sv.x * wf[4 * q] + sv.y * wf[4 * q + 1] + sv.z * wf[4 * q + 2] + sv.w * wf[4 * q + 3]; }
            s = wave_sum(s); if (lane == 0) SHW[b * NUP + n] = s; }
    }
}

__global__ void __launch_bounds__(NWAVES * 64, 2) skel_fwd(Args args) {
    extern __shared__ __attribute__((aligned(16))) unsigned char lds_raw[];
    LAS unsigned char* lds = (LAS unsigned char*)lds_raw;
    const int tid = threadIdx.x, lane = tid & 63, wave = __builtin_amdgcn_readfirstlane(tid >> 6);
    const int G = gridDim.x; const int bx = blockIdx.x; const int vcu = (G % 8 == 0) ? (bx % 8) * (G / 8) + bx / 8 : bx;
    const int lo = args.ph_lo, hi = args.ph_hi;
#define IN(k) (lo <= (k) && (k) < hi)
    if (IN(0)) { p0_body(args, lds, tid, lane, wave, vcu, G); }
    if (IN(1)) { p1_body(args, lane, wave, vcu, G); }
#undef IN
}

template <class Epi, int MODE>
__global__ void __launch_bounds__(256) naive_gemm(const bf16* A, int lda, const bf16* Bt, int ldb, int K, int ksplit, Epi epi) {
    __shared__ float As[32][65], Bs[32][65], Bs2[32][65];
    const int tid = threadIdx.x, tx = tid & 15, ty = tid >> 4;
    const int row0 = blockIdx.y * 64, col0 = blockIdx.x * 64;
    if (!epi.active(row0, col0)) return;
    const int poff = (MODE == 1) ? epi.pair_off(col0) : 0;
    float acc[4][4], acc2[4][4];
#pragma unroll
    for (int i = 0; i < 4; ++i)
#pragma unroll
        for (int j = 0; j < 4; ++j) { acc[i][j] = 0.f; acc2[i][j] = 0.f; }
    const int lr = tid >> 2, kc = (tid & 3) * 8;
    for (int k0 = 0; k0 < K; k0 += 32) {
        { const v4u av = *(const v4u*)(A + (size_t)(row0 + lr) * lda + k0 + kc); const v4u bv = *(const v4u*)(Bt + (size_t)(col0 + lr) * ldb + k0 + kc);
          const unsigned aw[4] = {av.x, av.y, av.z, av.w}, bw[4] = {bv.x, bv.y, bv.z, bv.w};
#pragma unroll
          for (int i = 0; i < 4; ++i) { As[kc + 2 * i][lr] = bf2f(aw[i] & 0xffff); As[kc + 2 * i + 1][lr] = bf2f(aw[i] >> 16); Bs[kc + 2 * i][lr] = bf2f(bw[i] & 0xffff); Bs[kc + 2 * i + 1][lr] = bf2f(bw[i] >> 16); }
          if (MODE == 1) { const v4u cv = *(const v4u*)(Bt + (size_t)(col0 + poff + lr) * ldb + k0 + kc); const unsigned cw[4] = {cv.x, cv.y, cv.z, cv.w};
#pragma unroll
              for (int i = 0; i < 4; ++i) { Bs2[kc + 2 * i][lr] = bf2f(cw[i] & 0xffff); Bs2[kc + 2 * i + 1][lr] = bf2f(cw[i] >> 16); } } }
        __syncthreads();
        const bool second = (MODE == 2) && (k0 >= ksplit);
#pragma unroll 8
        for (int kk = 0; kk < 32; ++kk) {
            float av[4], bv[4], cv[4];
#pragma unroll
            for (int i = 0; i < 4; ++i) { av[i] = As[kk][ty * 4 + i]; bv[i] = Bs[kk][tx * 4 + i]; cv[i] = (MODE == 1) ? Bs2[kk][tx * 4 + i] : 0.f; }
            if (MODE == 2 && second) {
#pragma unroll
                for (int i = 0; i < 4; ++i)
#pragma unroll
                    for (int j = 0; j < 4; ++j) acc2[i][j] += av[i] * bv[j];
            } else {
#pragma unroll
                for (int i = 0; i < 4; ++i)
#pragma unroll
                    for (int j = 0; j < 4; ++j) { acc[i][j] += av[i] * bv[j]; if (MODE == 1) acc2[i][j] += av[i] * cv[j]; }
            }
        }
        __syncthreads();
    }
#pragma unroll
    for (int i = 0; i < 4; ++i) epi(row0 + ty * 4 + i, col0 + tx * 4, acc[i], acc2[i]);
}

struct EpiN2 {
    unsigned char* ws;
    __device__ __forceinline__ bool active(int row0, int col0) const { const int pn = col0 >> 8, r = col0 & 255;
        if (row0 >= M && !(pn == 0 || pn == 2)) return false;
        if (pn == 2 && r >= 192) return false;
        if (((pn >= 3 && pn < 7) || pn >= 9) && r >= 128) return false;
        return true; }
    __device__ __forceinline__ int pair_off(int col0) const { const int pn = col0 >> 8; return ((pn >= 3 && pn < 7) || pn >= 9) ? 128 : 0; }
    __device__ __forceinline__ void operator()(int row, int n, const float* v, const float* v2) const {
        const int pn = n >> 8, r = n & 255;
        if (pn == 0) { bf16* o = (bf16*)(ws + WS_KVLAT) + (size_t)row * KVL + r; *(v2u*)o = (v2u){pk2(v[0], v[1]), pk2(v[2], v[3])}; return; }
        if (pn == 1 || (pn == 2 && r < 128)) { if (row >= M) return; bf16* o = (bf16*)(ws + WS_QLAT) + (size_t)row * QL + (pn == 1 ? r : 256 + r); *(v2u*)o = (v2u){pk2(v[0], v[1]), pk2(v[2], v[3])}; return; }
        if (pn == 2) { if (r >= 160) return; const int jj = r - 128; int b, tk; kv_row(row, b, tk); float o0 = v[0], o1 = v[1], o2 = v[2], o3 = v[3];
            if (row < M) { const float* rp = (const float*)(ws + WS_ROPE) + ((size_t)(row & 2047) * 16 + (jj >> 1)) * 2; const float c0 = rp[0], s0 = rp[1], c1 = rp[2], s1 = rp[3];
                o0 = v[0] * c0 - v[1] * s0; o1 = v[0] * s0 + v[1] * c0; o2 = v[2] * c1 - v[3] * s1; o3 = v[2] * s1 + v[3] * c1; }
            const v2u w = (v2u){pk2(o0, o1), pk2(o2, o3)};
            for (int h = 0; h < NH; ++h) *(v2u*)((bf16*)(ws + WS_KB) + ((size_t)(b * NH + h) * TK + tk) * DQK + DN + jj) = w;
            return; }
        if (pn < 7) { bf16* o = (bf16*)(ws + WS_S) + (size_t)row * CD + 128 * (pn - 3) + r; *(v2u*)o = (v2u){pk2(v[0] * v2[0], v[1] * v2[1]), pk2(v[2] * v2[2], v[3] * v2[3])}; return; }
        if (pn < 9) { bf16* o = (bf16*)(ws + WS_BG) + (size_t)row * CD + (n - 7 * 256); *(v2u*)o = (v2u){pk2(v[0], v[1]), pk2(v[2], v[3])}; return; }
        { const size_t off = (size_t)row * D + 128 * (pn - 9) + r; float ra[4], gc[4];
#pragma unroll
          for (int i = 0; i < 4; ++i) { const float ga = sigm_f(v[i]); gc[i] = sigm_f(v2[i]); ra[i] = ga / gc[i]; }
          *(v2u*)((bf16*)(ws + WS_RAT) + off) = (v2u){pk2(ra[0], ra[1]), pk2(ra[2], ra[3])}; *(v2u*)((bf16*)(ws + WS_GC) + off) = (v2u){pk2(gc[0], gc[1]), pk2(gc[2], gc[3])}; }
    }
};
__global__ void __launch_bounds__(256) naive_ssq_bf16(const bf16* src, int ncols, int nrows, float* out, int np) {
    const int row = blockIdx.x * 4 + (threadIdx.x >> 6), lane = threadIdx.x & 63; if (row >= nrows) return;
    float s = 0.f; for (int c = lane; c < ncols; c += 64) { const float v = bf2f(src[(size_t)row * ncols + c]); s += v * v; }
    s = wave_sum(s); if (lane < np) out[(size_t)row * np + lane] = lane == 0 ? s : 0.f;
}
__global__ void __launch_bounds__(256) naive_ssq_f32(const float* src, int ncols, int nrows, float* out, int np) {
    const int row = blockIdx.x * 4 + (threadIdx.x >> 6), lane = threadIdx.x & 63; if (row >= nrows) return;
    float s = 0.f; for (int c = lane; c < ncols; c += 64) { const float v = src[(size_t)row * ncols + c]; s += v * v; }
    s = wave_sum(s); if (lane < np) out[(size_t)row * np + lane] = lane == 0 ? s : 0.f;
}
struct EpiN3Q {
    unsigned char* ws; unsigned char* dob;
    __device__ __forceinline__ bool active(int, int) const { return true; }
    __device__ __forceinline__ int pair_off(int) const { return 0; }
    __device__ __forceinline__ void operator()(int row, int n, const float* v, const float*) const {
        const float* sp = (const float*)(ws + WS_SSQQ) + (size_t)row * 8; float ss = 0.f;
#pragma unroll
        for (int i = 0; i < 8; ++i) ss += sp[i];
        const float rs = 1.f / sqrtf(ss * (1.f / QL) + EPS) * QSCALE;
        const int h = n / DQK, d = n % DQK, b = row >> 11, t = row & 2047;
        float o0 = v[0] * rs, o1 = v[1] * rs, o2 = v[2] * rs, o3 = v[3] * rs;
        if (d >= DN) { const int jj = d - DN; const float* rp = (const float*)(ws + WS_ROPE) + ((size_t)t * 16 + (jj >> 1)) * 2; const float c0 = rp[0], s0 = rp[1], c1 = rp[2], s1 = rp[3];
            const float a0 = o0, a1 = o1, a2 = o2, a3 = o3; o0 = a0 * c0 - a1 * s0; o1 = a0 * s0 + a1 * c0; o2 = a2 * c1 - a3 * s1; o3 = a2 * s1 + a3 * c1; }
        *(v2u*)((bf16*)(dob + DO_QB) + ((size_t)(b * NH + h) * T + t) * DQK + d) = (v2u){pk2(o0, o1), pk2(o2, o3)};
    }
};
struct EpiN3KV {
    unsigned char* ws; unsigned char* dob;
    __device__ __forceinline__ bool active(int, int) const { return true; }
    __device__ __forceinline__ int pair_off(int) const { return 0; }
    __device__ __forceinline__ void operator()(int row, int n, const float* v, const float*) const {
        const float* sp = (const float*)(ws + WS_SSQKV) + (size_t)row * 4; const float ss = (sp[0] + sp[1]) + (sp[2] + sp[3]);
        const float rs = 1.f / sqrtf(ss * (1.f / KVL) + EPS);
        const int h = n >> 7, e = n & 127; int b, tk; kv_row(row, b, tk);
        const v2u w = (v2u){pk2(v[0] * rs, v[1] * rs), pk2(v[2] * rs, v[3] * rs)};
        if (e < DN) *(v2u*)((bf16*)(ws + WS_KB) + ((size_t)(b * NH + h) * TK + tk) * DQK + e) = w;
        else *(v2u*)((bf16*)(dob + DO_VB) + ((size_t)(b * NH + h) * TK + tk) * DV + (e - DN)) = w;
    }
};
__global__ void __launch_bounds__(256) naive_conv(const float* cw, const float* cb, unsigned char* ws) {
    const size_t i = (size_t)blockIdx.x * 256 + threadIdx.x; if (i >= (size_t)M * CD) return;
    const int row = (int)(i / CD), ch = (int)(i % CD), t = row & 2047;
    const bf16* S = (const bf16*)(ws + WS_S); const bf16* BG = (const bf16*)(ws + WS_BG);
    float y = cb[ch] + cw[CD + ch] * bf2f(S[i]);
    if (t > 0) y += cw[ch] * bf2f(S[i - CD]);
    if (t < T - 1) y += cw[2 * CD + ch] * bf2f(S[i + CD]);
    ((bf16*)(ws + WS_ACAT))[(size_t)row * D + CD + ch] = (bf16)f2bf(bf2f(BG[i]) * y);
}
__global__ void __launch_bounds__(256) naive_attn(unsigned char* ws, unsigned char* dob) {
    __shared__ float Ks[64][97]; __shared__ float Vs[64][65];
    const int bh = blockIdx.y, qb = blockIdx.x, b = bh >> 3, h = bh & 7, tid = threadIdx.x, q = tid >> 2, part = tid & 3;
    const bf16* QB = (const bf16*)(dob + DO_QB) + ((size_t)bh * T + qb * 64 + q) * DQK + part * 24;
    const bf16* KB = (const bf16*)(ws + WS_KB) + (size_t)bh * TK * DQK;
    const bf16* VB = (const bf16*)(dob + DO_VB) + (size_t)bh * TK * DV;
    float qv[24];
#pragma unroll
    for (int i = 0; i < 24; ++i) qv[i] = bf2f(QB[i]);
    float m = -1e30f, l = 0.f, o[16];
#pragma unroll
    for (int i = 0; i < 16; ++i) o[i] = 0.f;
    for (int tile = 0; tile < TK / 64; ++tile) {
        { const int r = tid >> 2, c0 = (tid & 3) * 24; const bf16* kp = KB + ((size_t)tile * 64 + r) * DQK + c0;
#pragma unroll
          for (int i = 0; i < 24; ++i) Ks[r][c0 + i] = bf2f(kp[i]);
          const int c1 = (tid & 3) * 16; const bf16* vp = VB + ((size_t)tile * 64 + r) * DV + c1;
#pragma unroll
          for (int i = 0; i < 16; ++i) Vs[r][c1 + i] = bf2f(vp[i]); }
        __syncthreads();
        for (int k = 0; k < 64; ++k) {
            float s = 0.f;
#pragma unroll
            for (int i = 0; i < 24; ++i) s += qv[i] * Ks[k][part * 24 + i];
            s += __shfl_xor(s, 1); s += __shfl_xor(s, 2);
            const float mn = fmaxf(m, s), alpha = exp2f(m - mn), p = exp2f(s - mn);
            l = l * alpha + p;
#pragma unroll
            for (int i = 0; i < 16; ++i) o[i] = o[i] * alpha + p * Vs[k][part * 16 + i];
            m = mn;
        }
        __syncthreads();
    }
    const float rl = 1.f / l;
    bf16* op = (bf16*)(ws + WS_ACAT) + ((size_t)(b * T + qb * 64 + q)) * D + h * DV + part * 16;
#pragma unroll
    for (int i = 0; i < 16; ++i) op[i] = (bf16)f2bf(o[i] * rl);
}
struct EpiN5 {
    unsigned char* ws;
    __device__ __forceinline__ bool active(int, int) const { return true; }
    __device__ __forceinline__ int pair_off(int) const { return 0; }
    __device__ __forceinline__ void operator()(int row, int n, const float* v, const float* v2) const {
        const size_t off = (size_t)row * D + n; const bf16* ra = (const bf16*)(ws + WS_RAT) + off; const bf16* gc = (const bf16*)(ws + WS_GC) + off; float o[4];
#pragma unroll
        for (int i = 0; i < 4; ++i) o[i] = bf2f(gc[i]) * (bf2f(ra[i]) * v[i] + v2[i]);
        *(v2u*)((bf16*)(ws + WS_MERGED) + off) = (v2u){pk2(o[0], o[1]), pk2(o[2], o[3])};
    }
};
struct EpiN6 {
    unsigned char* ws; const float* x; const float* n2g; float* out;
    __device__ __forceinline__ bool active(int, int) const { return true; }
    __device__ __forceinline__ int pair_off(int) const { return 0; }
    __device__ __forceinline__ void operator()(int row, int n, const float* v, const float*) const {
        const int b = row >> 11; const float* MOD = (const float*)(ws + WS_MOD) + b * MODW; const size_t off = (size_t)row * D + n; float x1[4], a2[4];
#pragma unroll
        for (int i = 0; i < 4; ++i) { x1[i] = x[off + i] + MOD[2 * D + n + i] * v[i]; a2[i] = x1[i] * n2g[n + i] * (1.f + MOD[4 * D + n + i]); }
        *(f32x4*)(out + off) = (f32x4){x1[0], x1[1], x1[2], x1[3]};
        *(v2u*)((bf16*)(ws + WS_A2) + off) = (v2u){pk2(a2[0], a2[1]), pk2(a2[2], a2[3])};
    }
};
__global__ void __launch_bounds__(256) naive_p7(unsigned char* ws) {
    __shared__ float As[32][69], Bs[32][65], Bs2[32][65];
    const int tid = threadIdx.x, tx = tid & 15, ty = tid >> 4;
    const int r0 = blockIdx.y * 64, bx = blockIdx.x, pn = bx >> 1, nb = pn * 256 + (bx & 1) * 64;
    const int ch0 = bx * 64;
    const bf16* A = (const bf16*)(ws + WS_A2); const bf16* Bt = (const bf16*)(ws + WS_WUP);
    float acc[6][4], acc2[6][4];
#pragma unroll
    for (int i = 0; i < 6; ++i)
#pragma unroll
        for (int j = 0; j < 4; ++j) { acc[i][j] = 0.f; acc2[i][j] = 0.f; }
    for (int k0 = 0; k0 < D; k0 += 32) {
        for (int c = tid; c < 66 * 4; c += 256) { const int lr = c >> 2, kc = (c & 3) * 8; int gr = r0 - 1 + lr; gr = gr < 0 ? 0 : (gr > M - 1 ? M - 1 : gr);
            const v4u av = *(const v4u*)(A + (size_t)gr * D + k0 + kc); const unsigned aw[4] = {av.x, av.y, av.z, av.w};
#pragma unroll
            for (int i = 0; i < 4; ++i) { As[kc + 2 * i][lr] = bf2f(aw[i] & 0xffff); As[kc + 2 * i + 1][lr] = bf2f(aw[i] >> 16); } }
        { const int lr = tid >> 2, kc = (tid & 3) * 8;
          const v4u bv = *(const v4u*)(Bt + (size_t)(nb + lr) * D + k0 + kc); const v4u cv = *(const v4u*)(Bt + (size_t)(nb + 128 + lr) * D + k0 + kc);
          const unsigned bw[4] = {bv.x, bv.y, bv.z, bv.w}, cw[4] = {cv.x, cv.y, cv.z, cv.w};
#pragma unroll
          for (int i = 0; i < 4; ++i) { Bs[kc + 2 * i][lr] = bf2f(bw[i] & 0xffff); Bs[kc + 2 * i + 1][lr] = bf2f(bw[i] >> 16); Bs2[kc + 2 * i][lr] = bf2f(cw[i] & 0xffff); Bs2[kc + 2 * i + 1][lr] = bf2f(cw[i] >> 16); } }
        __syncthreads();
#pragma unroll 4
        for (int kk = 0; kk < 32; ++kk) {
            float av[6], bv[4], cv[4];
#pragma unroll
            for (int i = 0; i < 6; ++i) av[i] = As[kk][ty * 4 + i];
#pragma unroll
            for (int j = 0; j < 4; ++j) { bv[j] = Bs[kk][tx * 4 + j]; cv[j] = Bs2[kk][tx * 4 + j]; }
#pragma unroll
            for (int i = 0; i < 6; ++i)
#pragma unroll
                for (int j = 0; j < 4; ++j) { acc[i][j] += av[i] * bv[j]; acc2[i][j] += av[i] * cv[j]; }
        }
        __syncthreads();
    }
    const float* SSQ2 = (const float*)(ws + WS_SSQ2); const float* SHW = (const float*)(ws + WS_SHW); const float* FCW = (const float*)(ws + WS_FCW); const float* FCB = (const float*)(ws + WS_FCB);
    float* HALO = (float*)(ws + WS_HALO);
    const int ng = nb + tx * 4, nv = ng + 128;
    float ug[6][4], uv[6][4];
#pragma unroll
    for (int i = 0; i < 6; ++i) { int gr = r0 + ty * 4 - 1 + i; gr = gr < 0 ? 0 : (gr > M - 1 ? M - 1 : gr); const int b = gr >> 11;
        float ss = 0.f;
#pragma unroll
        for (int q = 0; q < 16; ++q) ss += SSQ2[(size_t)gr * 16 + q];
        const float rs = 1.f / sqrtf(ss * (1.f / D) + EPS);
#pragma unroll
        for (int j = 0; j < 4; ++j) { ug[i][j] = rs * acc[i][j] + SHW[b * NUP + ng + j]; uv[i][j] = rs * acc2[i][j] + SHW[b * NUP + nv + j]; } }
#pragma unroll
    for (int i = 1; i < 5; ++i) { const int gr = r0 + ty * 4 - 1 + i, t = gr & 2047; float o[4];
#pragma unroll
        for (int j = 0; j < 4; ++j) {
            float cg = FCB[ng + j] + FCW[NUP + ng + j] * ug[i][j], cv = FCB[nv + j] + FCW[NUP + nv + j] * uv[i][j];
            if (t > 0) { cg += FCW[ng + j] * ug[i - 1][j]; cv += FCW[nv + j] * uv[i - 1][j]; }
            if (t < T - 1) { cg += FCW[2 * NUP + ng + j] * ug[i + 1][j]; cv += FCW[2 * NUP + nv + j] * uv[i + 1][j]; }
            o[j] = silu_f(cg) * cv; }
        *(v2u*)((bf16*)(ws + WS_ACT) + (size_t)gr * FF + ch0 + tx * 4) = (v2u){pk2(o[0], o[1]), pk2(o[2], o[3])};
        const int rr = gr & 255; const int hi = rr == 0 ? 0 : rr == 1 ? 1 : rr == 254 ? 2 : rr == 255 ? 3 : -1;
        if (hi >= 0) { float* hp = HALO + ((size_t)(gr >> 8) * 4 + hi) * NUP;
#pragma unroll
            for (int j = 0; j < 4; ++j) { hp[ng + j] = ug[i][j]; hp[nv + j] = uv[i][j]; } }
    }
}
struct EpiN9 {
    unsigned char* ws; float* out;
    __device__ __forceinline__ bool active(int, int) const { return true; }
    __device__ __forceinline__ int pair_off(int) const { return 0; }
    __device__ __forceinline__ void operator()(int row, int n, const float* v, const float*) const {
        const int b = row >> 11; const float* MOD = (const float*)(ws + WS_MOD) + b * MODW; const size_t off = (size_t)row * D + n; f32x4 x1 = *(const f32x4*)(out + off);
        x1.x += MOD[5 * D + n] * v[0]; x1.y += MOD[5 * D + n + 1] * v[1]; x1.z += MOD[5 * D + n + 2] * v[2]; x1.w += MOD[5 * D + n + 3] * v[3];
        *(f32x4*)(out + off) = x1;
    }
};
__global__ void __launch_bounds__(256) naive_final(float* out, const float* ssq3, const float* fg) {
    const int row = blockIdx.x * 4 + (threadIdx.x >> 6), lane = threadIdx.x & 63;
    float ss = 0.f;
#pragma unroll
    for (int q = 0; q < 16; ++q) ss += ssq3[(size_t)row * 16 + q];
    const float rs = 1.f / sqrtf(ss * (1.f / D) + EPS);
    f32x4* o4 = (f32x4*)(out + (size_t)row * D) + lane; const f32x4* g4 = (const f32x4*)fg + lane;
#pragma unroll
    for (int j = 0; j < 4; ++j) o4[64 * j] = o4[64 * j] * rs * g4[64 * j];
}

extern "C" void kernel_launch(void* const* d_in, const int* in_sizes, int n_in, void* d_out, int out_size, void* d_ws, size_t ws_size, hipStream_t stream) {
    static int grid = 0;
    if (grid == 0) {
        if (n_in != 23 || in_sizes[0] != M * D || out_size != M * D || ws_size < WS_END) { fprintf(stderr, "kernel_launch: unexpected shapes (n_in %d, in0 %d, out %d, ws %zu)\n", n_in, n_in > 0 ? in_sizes[0] : -1, out_size, ws_size); grid = -1; return; }
        int dev = 0, cus = 0, per_cu = 0;
        if (hipGetDevice(&dev) != hipSuccess || hipDeviceGetAttribute(&cus, hipDeviceAttributeMultiprocessorCount, dev) != hipSuccess) { grid = -1; return; }
        if (hipFuncSetAttribute((const void*)skel_fwd, hipFuncAttributeMaxDynamicSharedMemorySize, LDS_BYTES) != hipSuccess) { fprintf(stderr, "kernel_launch: hipFuncSetAttribute failed\n"); grid = -1; return; }
        if (hipOccupancyMaxActiveBlocksPerMultiprocessor(&per_cu, (const void*)skel_fwd, NWAVES * 64, LDS_BYTES) != hipSuccess || per_cu < 1) { fprintf(stderr, "kernel_launch: occupancy query says %d\n", per_cu); per_cu = 1; }
        (void)hipGetLastError();
        grid = cus * 1;
    }
    if (grid < 0) return;
    unsigned char* ws = (unsigned char*)d_ws; unsigned char* dob = (unsigned char*)d_out;
    (void)hipMemsetAsync(ws + WS_CTL, 0, CTL_ZERO_BYTES, stream);
    Args a{};
    for (int i = 0; i < 23; ++i) a.in[i] = (const float*)d_in[i];
    a.out = (float*)d_out; a.ws = ws;
    const float* const* in = (const float* const*)d_in;
    a.ph_lo = 0; a.ph_hi = 1; hipLaunchKernelGGL(skel_fwd, dim3(grid), dim3(NWAVES * 64), LDS_BYTES, stream, a);
    a.ph_lo = 1; a.ph_hi = 2; hipLaunchKernelGGL(skel_fwd, dim3(grid), dim3(NWAVES * 64), LDS_BYTES, stream, a);
    hipLaunchKernelGGL((naive_gemm<EpiN2, 1>), dim3(NIN / 64, MKV / 64), dim3(256), 0, stream, (const bf16*)(dob + DO_H), D, (const bf16*)(ws + WS_WIN), D, D, 0, EpiN2{ws});
    hipLaunchKernelGGL(naive_ssq_bf16, dim3(MKV / 4), dim3(256), 0, stream, (const bf16*)(ws + WS_KVLAT), KVL, MKV, (float*)(ws + WS_SSQKV), 4);
    hipLaunchKernelGGL(naive_ssq_bf16, dim3(M / 4), dim3(256), 0, stream, (const bf16*)(ws + WS_QLAT), QL, M, (float*)(ws + WS_SSQQ), 8);
    hipLaunchKernelGGL((naive_gemm<EpiN3Q, 0>), dim3(768 / 64, M / 64), dim3(256), 0, stream, (const bf16*)(ws + WS_QLAT), QL, (const bf16*)(ws + WS_WUQ), QL, QL, 0, EpiN3Q{ws, dob});
    hipLaunchKernelGGL((naive_gemm<EpiN3KV, 0>), dim3(1024 / 64, MKV / 64), dim3(256), 0, stream, (const bf16*)(ws + WS_KVLAT), KVL, (const bf16*)(ws + WS_WUKV), KVL, KVL, 0, EpiN3KV{ws, dob});
    hipLaunchKernelGGL(naive_conv, dim3((M * CD) / 256), dim3(256), 0, stream, in[I_CW], in[I_CB], ws);
    hipLaunchKernelGGL(naive_attn, dim3(T / 64, NB * NH), dim3(256), 0, stream, ws, dob);
    hipLaunchKernelGGL((naive_gemm<EpiN5, 2>), dim3(D / 64, M / 64), dim3(256), 0, stream, (const bf16*)(ws + WS_ACAT), D, (const bf16*)(ws + WS_WCAT), D, D, 512, EpiN5{ws});
    hipLaunchKernelGGL((naive_gemm<EpiN6, 0>), dim3(D / 64, M / 64), dim3(256), 0, stream, (const bf16*)(ws + WS_MERGED), D, (const bf16*)(ws + WS_WO), D, D, 0, EpiN6{ws, in[I_X], in[I_N2G], (float*)d_out});
    hipLaunchKernelGGL(naive_ssq_f32, dim3(M / 4), dim3(256), 0, stream, (const float*)d_out, D, M, (float*)(ws + WS_SSQ2), 16);
    hipLaunchKernelGGL(naive_p7, dim3(FF / 64, M / 64), dim3(256), 0, stream, ws);
    hipLaunchKernelGGL((naive_gemm<EpiN9, 0>), dim3(D / 64, M / 64), dim3(256), 0, stream, (const bf16*)(ws + WS_ACT), FF, (const bf16*)(ws + WS_WDOWN), FF, FF, 0, EpiN9{ws, (float*)d_out});
    hipLaunchKernelGGL(naive_ssq_f32, dim3(M / 4), dim3(256), 0, stream, (const float*)d_out, D, M, (float*)(ws + WS_SSQ3), 16);
    hipLaunchKernelGGL(naive_final, dim3(M / 4), dim3(256), 0, stream, (float*)d_out, (const float*)(ws + WS_SSQ3), in[I_FG]);
}
```

```cpp
#include <hip/hip_runtime.h>
#include <cstdio>
#include <cstdint>

#define LAS __attribute__((address_space(3)))
#define GAS __attribute__((address_space(1)))
typedef unsigned short bf16;
typedef unsigned v4u __attribute__((ext_vector_type(4)));
typedef unsigned v2u __attribute__((ext_vector_type(2)));
typedef float f32x4 __attribute__((ext_vector_type(4)));
typedef float f32x2 __attribute__((ext_vector_type(2)));
typedef short bf16x8 __attribute__((ext_vector_type(8)));

constexpr int NB = 8, T = 2048, D = 1024, CTXL = 256, NH = 8, DN = 64, DR = 32, DQK = 96, DV = 64, QL = 384, KVL = 256, CD = 512, FF = 2816;
constexpr int TK = CTXL + T;
constexpr int M = NB * T;
constexpr int MC = NB * CTXL;
constexpr int MKV = M + MC;
constexpr int NIN = 4352;
constexpr int NUP = 2 * FF;
constexpr float EPS = 1e-6f;
constexpr float QSCALE = 0.10206207261596575f * 1.4426950408889634f;
constexpr int MODW = 6 * D;

constexpr size_t MiB = 1u << 20;
constexpr size_t WS_CTL = 0, CTL_ZERO_BYTES = 1 * MiB;
constexpr size_t WS_MOD = 1 * MiB;
constexpr size_t WS_ROPE = 1 * MiB + 256 * 1024;
constexpr size_t WS_SHW = 1 * MiB + 512 * 1024;
constexpr size_t WS_FCW = 1 * MiB + 768 * 1024;
constexpr size_t WS_FCB = 1 * MiB + 896 * 1024;
constexpr size_t WS_SSQKV = 2 * MiB;
constexpr size_t WS_SSQQ = 2 * MiB + 512 * 1024;
constexpr size_t WS_SSQ2 = 3 * MiB;
constexpr size_t WS_SSQ3 = 4 * MiB;
constexpr size_t WS_WIN = 8 * MiB;
constexpr size_t WS_WUQ = 17 * MiB;
constexpr size_t WS_WUKV = 18 * MiB;
constexpr size_t WS_WCAT = 19 * MiB;
constexpr size_t WS_WO = 21 * MiB;
constexpr size_t WS_WUP = 23 * MiB;
constexpr size_t WS_WDOWN = 34 * MiB;
constexpr size_t WS_KVLAT = 40 * MiB;
constexpr size_t WS_QLAT = 49 * MiB;
constexpr size_t WS_S = 61 * MiB;
constexpr size_t WS_BG = 77 * MiB;
constexpr size_t WS_RAT = 93 * MiB;
constexpr size_t WS_GC = 125 * MiB;
constexpr size_t WS_KB = 157 * MiB;
constexpr size_t WS_ACAT = 184 * MiB;
constexpr size_t WS_MERGED = 216 * MiB;
constexpr size_t WS_A2 = 93 * MiB;
constexpr size_t WS_ACT = 125 * MiB;
constexpr size_t WS_HALO = 216 * MiB;
constexpr size_t WS_END = 256 * MiB;
constexpr size_t DO_H = 0;
constexpr size_t DO_QB = 0;
constexpr size_t DO_VB = 24 * MiB;

__device__ __forceinline__ float bf2f(unsigned v) { return __uint_as_float(v << 16); }
__host__ __device__ __forceinline__ unsigned f2bf(float f) { unsigned u = __builtin_bit_cast(unsigned, f); return (u + 0x7fffu + ((u >> 16) & 1u)) >> 16; }
__device__ __forceinline__ unsigned pk2(float lo, float hi) { return f2bf(lo) | (f2bf(hi) << 16); }
__device__ __forceinline__ float silu_f(float x) { return x / (1.f + __expf(-x)); }
__device__ __forceinline__ float sigm_f(float x) { return 1.f / (1.f + __expf(-x)); }
__device__ __forceinline__ int lane_id() { int l; asm volatile("v_mbcnt_lo_u32_b32 %0, -1, 0\n\tv_mbcnt_hi_u32_b32 %0, -1, %0" : "=v"(l)); return l; }
__device__ __forceinline__ float wave_sum(float v) {
#pragma unroll
    for (int o = 1; o < 64; o <<= 1) v += __shfl_xor(v, o);
    return v;
}
__host__ __device__ __forceinline__ int rope_orig(int j) { const int p = j & 1, kf = j >> 1, a = kf >> 3, f = kf & 7; return a * 16 + p * 8 + f; }
__host__ __device__ __forceinline__ int win_map(int n) {
    const int pn = n >> 8, r = n & 255;
    if (pn == 0) return r;
    if (pn == 1) return 288 + r;
    if (pn == 2) { if (r < 128) return 544 + r; if (r < 160) return 256 + rope_orig(r - 128); return -1; }
    if (pn < 7) { const int j = pn - 3; return r < 128 ? 672 + 128 * j + r : 1696 + 128 * j + (r - 128); }
    if (pn < 9) return 1184 + (n - 7 * 256);
    { const int j = pn - 9; return r < 128 ? 2208 + 128 * j + r : 3232 + 128 * j + (r - 128); }
}
__host__ __device__ __forceinline__ int wuq_map(int n) { const int h = n / 96, d = n % 96; return d < 64 ? n : h * 96 + 64 + rope_orig(d - 64); }
__host__ __device__ __forceinline__ int wup_map(int n) { const int pn = n >> 8, r = n & 255; return r < 128 ? 128 * pn + r : FF + 128 * pn + (r - 128); }
__host__ __device__ __forceinline__ int ident_map(int n) { return n; }
struct WinMap { __device__ __forceinline__ int operator()(int n) const { return win_map(n); } };
struct WuqMap { __device__ __forceinline__ int operator()(int n) const { return wuq_map(n); } };
struct WupMap { __device__ __forceinline__ int operator()(int n) const { return wup_map(n); } };
struct IdMap { __device__ __forceinline__ int operator()(int n) const { return n; } };
__device__ __forceinline__ void kv_row(int row, int& b, int& tk) { if (row < M) { b = row >> 11; tk = CTXL + (row & 2047); } else { const int r = row - M; b = r >> 8; tk = r & 255; } }

constexpr int NWAVES = 8;
constexpr int LDS_BYTES = 147456;
struct Args { const float* in[23]; float* out; unsigned char* ws; int ph_lo, ph_hi, li, pad; };
enum { I_X = 0, I_C, I_CTX, I_CCTX, I_WADA, I_BADA, I_N1G, I_WIN, I_QNG, I_KVNG, I_WUQ, I_WUKV, I_CW, I_CB, I_WAO, I_WCO, I_WO, I_N2G, I_WUP, I_FCW, I_FCB, I_WDOWN, I_FG };

namespace pg8 {
#define PG8_LAS __attribute__((address_space(3)))
typedef unsigned short bf16_t;
typedef short bf16x8 __attribute__((ext_vector_type(8)));
typedef float f32x4 __attribute__((ext_vector_type(4)));
typedef unsigned u32x4 __attribute__((ext_vector_type(4)));
constexpr int BM = 256, BK = 64, HALF = 128, HTB = HALF * BK * 2  , STAGE_BYTES = 8 * HTB, NXCD = 8, WGM = 8;

__host__ __device__ __forceinline__ int lds_byte(int r, int c) { const int st = (r >> 4) * 2 + (c >> 5), rr = r & 15, cc = c & 31, ob = rr * 64 + cc * 2; return st * 1024 + (ob ^ (((ob >> 9) & 1) << 5)); }
__host__ __device__ __forceinline__ void stage_rc(int b, int& R, int& C) { const int st = b / 1024, sb = b % 1024, swz = sb ^ (((sb >> 9) & 1) << 5); R = (st >> 1) * 16 + swz / 64; C = (st & 1) * 32 + (swz % 64) / 2; }
__host__ __device__ __forceinline__ int perm32(int rho) { const int n = rho >> 4, i = rho & 15; return 8 * (i >> 2) + 4 * n + (i & 3); }

struct Unit { int pm, pn; };
struct Gemm { const bf16_t* A; const bf16_t* Bt; int M, N, K; };

struct StaticOrder {
    int nM, nN, nwg, G, c;
    __host__ __device__ void init(int M, int N, int G_, int c_) { nM = M / BM; nN = N / BM; nwg = nM * nN; G = G_; c = c_; }
    __host__ __device__ bool next(int i, Unit& u) const {
        const long L = (long)i * G + c; if (L >= nwg) return false;
        int wgid = (int)L; { const int q = nwg / NXCD, r = nwg % NXCD, xcd = wgid % NXCD, off = wgid / NXCD; wgid = (xcd < r ? xcd * (q + 1) : r * (q + 1) + (xcd - r) * q) + off; }
        const int nig = WGM * nN, gid = wgid / nig, fm = gid * WGM, gsz = (nM - fm) < WGM ? (nM - fm) : WGM;
        u.pm = fm + ((wgid % nig) % gsz); u.pn = (wgid % nig) / gsz; return true;
    }
    __device__ __forceinline__ void a_ready(const Unit&) const {}
    __device__ __forceinline__ void done(const Unit&) const {}
};

__device__ __forceinline__ unsigned cvt_pk_bf16(float lo, float hi) { unsigned r; asm volatile("v_cvt_pk_bf16_f32 %0, %1, %2" : "=v"(r) : "v"(lo), "v"(hi)); return r; }
struct EpiBase { static constexpr bool HAS_MID = false, AFTER_DRAIN = false; };
template <class Epi, class Sched, bool ALIGN_EPI = false, bool SP2 = false>
__device__ __forceinline__ void gemm_phase(PG8_LAS unsigned char* lds, const Gemm g, const Sched& S, const Epi& E, const int wid) {
    int lane_ = lane_id(); asm volatile("" : "+v"(lane_));
    const int lane = lane_, tid = wid * 64 + lane, wr = wid >> 2, wc = wid & 3, fr = lane & 15, fq = lane >> 4;
    const int K = g.K, nt = K / BK;
    unsigned voffA[2], voffB[2];
#pragma unroll
    for (int i = 0; i < 2; ++i) { int R, C; stage_rc(tid * 16 + i * 8192, R, C); const int Rb = Epi::PERM ? ((R & ~31) + perm32(R & 31)) : R;
        voffA[i] = (unsigned)(R * K + C) * 2u; voffB[i] = (unsigned)(Rb * K + C) * 2u; }
    const size_t kstep = (size_t)(BK * 2);
    const size_t hstep = (size_t)HALF * K * 2;
    const size_t tstep = 2 * hstep;
    const unsigned ldsw = (unsigned)wid * 1024u;
    const int aoff = lds_byte(wr * 64 + fr, fq * 8), boff = lds_byte(wc * 32 + fr, fq * 8);
#define PG8_SA(b, h) (((b) * 2 + (h)) * HTB)
#define PG8_SB(b, h) ((4 + (b) * 2 + (h)) * HTB)
#define PG8_STAGE(bufoff, gbase, voff) do { _Pragma("unroll") for (int _i = 0; _i < 2; ++_i) \
        __builtin_amdgcn_global_load_lds((const unsigned*)((const char*)(gbase) + (voff)[_i]), (PG8_LAS unsigned*)(lds + (bufoff) + ldsw + _i * 8192), 16, 0, 0); } while (0)
#define PG8_LDA(dst, b, h) do { _Pragma("unroll") for (int m = 0; m < 4; ++m) _Pragma("unroll") for (int k = 0; k < 2; ++k) dst[m][k] = *(const PG8_LAS bf16x8*)(lds + PG8_SA(b, h) + aoff + m * 2048 + k * 1024); } while (0)
#define PG8_LDB(dst, b, h) do { _Pragma("unroll") for (int n = 0; n < 2; ++n) _Pragma("unroll") for (int k = 0; k < 2; ++k) dst[n][k] = *(const PG8_LAS bf16x8*)(lds + PG8_SB(b, h) + boff + n * 2048 + k * 1024); } while (0)
#define PG8_MMA(ai, bj, At, Bt) do { __builtin_amdgcn_s_setprio(1); _Pragma("unroll") for (int m = 0; m < 4; ++m) _Pragma("unroll") for (int n = 0; n < 2; ++n) _Pragma("unroll") for (int k = 0; k < 2; ++k) \
        acc[ai][bj][m][n] = __builtin_amdgcn_mfma_f32_16x16x32_bf16(Bt[n][k], At[m][k], acc[ai][bj][m][n], 0, 0, 0); __builtin_amdgcn_s_setprio(0); } while (0)
#define PG8_WAIT_V(n) asm volatile("s_waitcnt vmcnt(" #n ")" ::: "memory")
#define PG8_WAIT_L(n) asm volatile("s_waitcnt lgkmcnt(" #n ")" ::: "memory")
#define PG8_BAR __builtin_amdgcn_s_barrier()
#define PG8_SCHED __builtin_amdgcn_sched_barrier(0)
    Unit cur, nxt; int ui = 0;
    if (!S.next(0, cur)) return;
    f32x4 acc[2][2][4][2];
#pragma unroll
    for (int a = 0; a < 2; ++a)
#pragma unroll
        for (int b = 0; b < 2; ++b)
#pragma unroll
            for (int m = 0; m < 4; ++m)
#pragma unroll
                for (int n = 0; n < 2; ++n) acc[a][b][m][n] = (f32x4){0.f, 0.f, 0.f, 0.f};
    bf16x8 At[4][2], B0[2][2], B1[2][2];
    const char* cA = (const char*)g.A + (size_t)cur.pm * tstep; const char* cB = (const char*)g.Bt + (size_t)cur.pn * tstep;
    S.a_ready(cur);
    if constexpr (SP2) {
        PG8_STAGE(PG8_SB(0, 0), cB, voffB); PG8_STAGE(PG8_SB(0, 1), cB + hstep, voffB); PG8_STAGE(PG8_SA(0, 0), cA, voffA); PG8_STAGE(PG8_SA(0, 1), cA + hstep, voffA);
        if (wr == 1) PG8_BAR;
        PG8_WAIT_V(2); PG8_BAR;
        PG8_STAGE(PG8_SB(1, 0), cB + kstep, voffB); PG8_STAGE(PG8_SA(1, 0), cA + kstep, voffA); PG8_STAGE(PG8_SB(1, 1), cB + hstep + kstep, voffB);
        PG8_WAIT_V(6); PG8_BAR;
    } else {
        PG8_STAGE(PG8_SB(0, 0), cB, voffB); PG8_STAGE(PG8_SA(0, 0), cA, voffA); PG8_STAGE(PG8_SB(0, 1), cB + hstep, voffB); PG8_STAGE(PG8_SA(0, 1), cA + hstep, voffA);
        if (wr == 1) PG8_BAR;
        PG8_WAIT_V(4); PG8_BAR;
        PG8_STAGE(PG8_SB(1, 0), cB + kstep, voffB); PG8_STAGE(PG8_SA(1, 0), cA + kstep, voffA); PG8_STAGE(PG8_SB(1, 1), cB + hstep + kstep, voffB);
        PG8_WAIT_V(6); PG8_BAR;
    }
    for (;;) {
        const bool has_next = S.next(ui + 1, nxt);
        const char* nA = has_next ? (const char*)g.A + (size_t)nxt.pm * tstep : cA; const char* nB = has_next ? (const char*)g.Bt + (size_t)nxt.pn * tstep : cB;
        for (int t = 0; t < nt; t += 2) {
            if constexpr (Epi::HAS_MID) { if (t == E.mid_t()) E.mid(acc, cur, wr, wc, fr, fq); }
            const bool last = (t == nt - 2);
            const char* a1 = cA + (size_t)(t + 1) * kstep;
            const char* a2 = last ? nA : cA + (size_t)(t + 2) * kstep; const char* b2 = last ? nB : cB + (size_t)(t + 2) * kstep;
            const char* a3 = a2 + kstep; const char* b3 = b2 + kstep;
            if (last && has_next) S.a_ready(nxt);
            if constexpr (SP2) {
            PG8_LDB(B0, 0, 0); PG8_LDB(B1, 0, 1); PG8_SCHED; PG8_LDA(At, 0, 0); PG8_STAGE(PG8_SA(1, 1), a1 + hstep, voffA);
            PG8_WAIT_V(8); PG8_WAIT_L(0); PG8_BAR; PG8_MMA(0, 0, At, B0); PG8_MMA(0, 1, At, B1); PG8_BAR; PG8_SCHED;
            PG8_LDA(At, 0, 1); PG8_STAGE(PG8_SB(0, 0), b2, voffB); PG8_STAGE(PG8_SB(0, 1), b2 + hstep, voffB); PG8_STAGE(PG8_SA(0, 0), a2, voffA);
            PG8_WAIT_V(8); PG8_WAIT_L(0); PG8_BAR; PG8_MMA(1, 0, At, B0); PG8_MMA(1, 1, At, B1); PG8_BAR; PG8_SCHED;
            PG8_LDB(B0, 1, 0); PG8_LDB(B1, 1, 1); PG8_SCHED; PG8_LDA(At, 1, 0); PG8_STAGE(PG8_SA(0, 1), a2 + hstep, voffA);
            PG8_WAIT_V(8); PG8_WAIT_L(0); PG8_BAR; PG8_MMA(0, 0, At, B0); PG8_MMA(0, 1, At, B1); PG8_BAR; PG8_SCHED;
            PG8_LDA(At, 1, 1); PG8_STAGE(PG8_SB(1, 0), b3, voffB); PG8_STAGE(PG8_SB(1, 1), b3 + hstep, voffB); PG8_STAGE(PG8_SA(1, 0), a3, voffA);
            PG8_WAIT_V(8); PG8_WAIT_L(0); PG8_BAR; PG8_MMA(1, 0, At, B0); PG8_MMA(1, 1, At, B1); PG8_BAR; PG8_SCHED;
            } else {
            PG8_LDB(B0, 0, 0); PG8_SCHED; PG8_LDA(At, 0, 0); PG8_STAGE(PG8_SA(1, 1), a1 + hstep, voffA);
            PG8_WAIT_L(8); PG8_BAR; PG8_WAIT_L(0); PG8_MMA(0, 0, At, B0); PG8_BAR; PG8_SCHED;
            PG8_LDB(B1, 0, 1); PG8_STAGE(PG8_SB(0, 0), b2, voffB);
            PG8_BAR; PG8_WAIT_L(0); PG8_MMA(0, 1, At, B1); PG8_BAR;
            PG8_LDA(At, 0, 1); PG8_STAGE(PG8_SA(0, 0), a2, voffA);
            PG8_BAR; PG8_WAIT_L(0); PG8_MMA(1, 0, At, B0); PG8_BAR; PG8_SCHED;
            PG8_STAGE(PG8_SB(0, 1), b2 + hstep, voffB);
            PG8_WAIT_V(6); PG8_BAR; PG8_MMA(1, 1, At, B1); PG8_BAR;
            PG8_LDB(B0, 1, 0); PG8_SCHED; PG8_LDA(At, 1, 0); PG8_STAGE(PG8_SA(0, 1), a2 + hstep, voffA);
            PG8_WAIT_L(8); PG8_BAR; PG8_WAIT_L(0); PG8_MMA(0, 0, At, B0); PG8_BAR; PG8_SCHED;
            PG8_LDB(B1, 1, 1); PG8_STAGE(PG8_SB(1, 0), b3, voffB);
            PG8_BAR; PG8_WAIT_L(0); PG8_MMA(0, 1, At, B1); PG8_BAR;
            PG8_LDA(At, 1, 1); PG8_STAGE(PG8_SA(1, 0), a3, voffA);
            PG8_BAR; PG8_WAIT_L(0); PG8_MMA(1, 0, At, B0); PG8_BAR; PG8_SCHED;
            PG8_STAGE(PG8_SB(1, 1), b3 + hstep, voffB);
            PG8_WAIT_V(6); PG8_BAR; PG8_MMA(1, 1, At, B1); PG8_BAR;
            }
        }
        if constexpr (ALIGN_EPI) { if (wr == 0) PG8_BAR; }
        if constexpr (!Epi::AFTER_DRAIN) { E(acc, cur, wr, wc, fr, fq); S.done(cur); }
        if (!has_next) break;
#pragma unroll
        for (int a = 0; a < 2; ++a)
#pragma unroll
            for (int b = 0; b < 2; ++b)
#pragma unroll
                for (int m = 0; m < 4; ++m)
#pragma unroll
                    for (int n = 0; n < 2; ++n) acc[a][b][m][n] = (f32x4){0.f, 0.f, 0.f, 0.f};
        cur = nxt; cA = nA; cB = nB; ++ui;
        if constexpr (ALIGN_EPI) { if (wr == 1) PG8_BAR; }
    }
    PG8_WAIT_V(0);
    if constexpr (!ALIGN_EPI) { if (wr == 0) PG8_BAR; }
    PG8_BAR;
    if constexpr (Epi::AFTER_DRAIN) { E.fused(acc, cur, wr, wc, fr, fq, lds, wid, lane); S.done(cur); }
#undef PG8_SA
#undef PG8_SB
#undef PG8_STAGE
#undef PG8_LDA
#undef PG8_LDB
#undef PG8_MMA
#undef PG8_WAIT_V
#undef PG8_WAIT_L
#undef PG8_BAR
#undef PG8_SCHED
}
}
constexpr int RING_OFF = 0, RING_BYTES = 131072;
constexpr int LDSCTL_OFF = RING_BYTES, MISC_OFF = LDSCTL_OFF + 320;
constexpr int CW_TMO = 0, CW_CODE = 1, CW_BAR = 4096;
typedef GAS unsigned gu32;
#define XB_TMO      128
#define XB_XCNT(j)  (256  + 64 * (j))
#define XB_XSUB(j)  (1280 + 64 * (j))
#define XB_XGEN(j)  (2304 + 64 * (j))
#define XB_TOP      3328
#define XB_TOPGEN   3392
#define XCD_BAR_WORDS 3456
#define XB_SPIN_CAP (1u << 18)

__device__ __forceinline__ unsigned xb_ld(unsigned* p)              { return __hip_atomic_load(p, __ATOMIC_RELAXED, __HIP_MEMORY_SCOPE_AGENT); }
__device__ __forceinline__ unsigned xb_add(unsigned* p, unsigned v) { return __hip_atomic_fetch_add(p, v, __ATOMIC_RELAXED, __HIP_MEMORY_SCOPE_AGENT); }
__device__ __forceinline__ unsigned xb_xcc_id() { return (unsigned)__builtin_amdgcn_s_getreg((3 << 11) | 20) & 0xFu; }
#define XB_SPIN(cond, bar) do { unsigned _sp = 0; while (cond) { __builtin_amdgcn_s_sleep(1); \
    if ((++_sp & 255u) == 0u) { if (xb_ld(&(bar)[XB_TMO])) break; if (_sp > XB_SPIN_CAP) { atomicAdd(&(bar)[XB_TMO], 1u); break; } } } } while (0)

struct XcdBarrier {
    unsigned* bar; unsigned x;
    volatile LAS unsigned* st;
};

__device__ __forceinline__ XcdBarrier xcd_barrier_post(unsigned* bar, volatile LAS unsigned* st, bool leader) {
    XcdBarrier b; b.bar = bar; b.x = xb_xcc_id(); b.st = st;
    if (leader) (void)xb_add(&bar[XB_XCNT(b.x)], 1u);
    return b;
}
__device__ __forceinline__ void xcd_barrier_complete(unsigned* bar, unsigned x, unsigned& nloc, unsigned& nx) {
    const unsigned G = gridDim.x * gridDim.y * gridDim.z;
    unsigned sum, cnt, mine, sp = 0u;
    for (;;) {
        sum = 0u; cnt = 0u; mine = 0u;
#pragma unroll
        for (unsigned j = 0; j < 16; ++j) { const unsigned c = xb_ld(&bar[XB_XCNT(j)]); sum += c; cnt += (c > 0u) ? 1u : 0u; mine = (j == x) ? c : mine; }
        if (sum == G) break;
        __builtin_amdgcn_s_sleep(1);
        if ((++sp & 255u) == 0u) { if (xb_ld(&bar[XB_TMO])) break; if (sp > XB_SPIN_CAP) { atomicAdd(&bar[XB_TMO], 1u); break; } }
    }
    nloc = mine > 0u ? mine : 1u; nx = cnt > 0u ? cnt : 1u;
}

__device__ __forceinline__ void xcd_barrier(const XcdBarrier& b, bool leader) {
    asm volatile("s_waitcnt vmcnt(0)" ::: "memory");
    __syncthreads();
    if (leader) {
        unsigned* bar = b.bar;
        __builtin_amdgcn_s_waitcnt(0);
        unsigned nloc = b.st[0], nx = b.st[1];
        if (nloc == 0u) { xcd_barrier_complete(bar, b.x, nloc, nx); b.st[0] = nloc; b.st[1] = nx; }
        const unsigned old = xb_add(&bar[XB_XSUB(b.x)], 1u);
        const unsigned gen = old / nloc;
        if (old + 1u == (gen + 1u) * nloc) {
            __builtin_amdgcn_fence(__ATOMIC_RELEASE, "agent");
            asm volatile("s_waitcnt vmcnt(0)" ::: "memory");
            const unsigned og = xb_add(&bar[XB_TOP], 1u);
            const unsigned tg = og / nx;
            if (og + 1u == (tg + 1u) * nx) xb_add(&bar[XB_TOPGEN], 1u);
            else XB_SPIN(xb_ld(&bar[XB_TOPGEN]) == tg, bar);
            __builtin_amdgcn_fence(__ATOMIC_ACQUIRE, "agent");
            xb_add(&bar[XB_XGEN(b.x)], 1u);
            asm volatile("s_waitcnt vmcnt(0)" ::: "memory");
        } else {
            XB_SPIN(xb_ld(&bar[XB_XGEN(b.x)]) == gen, bar);
            __builtin_amdgcn_fence(__ATOMIC_ACQUIRE, "agent");
            asm volatile("s_waitcnt vmcnt(0)" ::: "memory");
        }
    }
    __syncthreads();
}
#define PACK8(a, b) (v4u){pg8::cvt_pk_bf16((a)[0], (a)[1]), pg8::cvt_pk_bf16((a)[2], (a)[3]), pg8::cvt_pk_bf16((b)[0], (b)[1]), pg8::cvt_pk_bf16((b)[2], (b)[3])}
__device__ __forceinline__ float dot4(const f32x4 a) { return (a[0] * a[0] + a[1] * a[1]) + (a[2] * a[2] + a[3] * a[3]); }
__device__ __forceinline__ float ex2(float x) { return __builtin_amdgcn_exp2f(x); }
__device__ __forceinline__ float rcp(float x) { return __builtin_amdgcn_rcpf(x); }

struct SchedP2 {
    pg8::StaticOrder so;
    __device__ __forceinline__ void init(int G, int c) { so.init(M, NIN, G, c); }
    __device__ __forceinline__ bool next(int i, pg8::Unit& u) const {
        const long L = (long)i * so.G + so.c;
        if (L < so.nwg) return so.next(i, u);
        const int e = (int)(L - so.nwg); if (e >= 16) return false;
        u.pm = 64 + (e >> 1); u.pn = (e & 1) * 2; return true;
    }
    __device__ __forceinline__ void a_ready(const pg8::Unit&) const {}
    __device__ __forceinline__ void done(const pg8::Unit&) const {}
};
struct EpiP2 : pg8::EpiBase {
    static constexpr bool PERM = true;
    unsigned char* ws;
    __device__ __forceinline__ void operator()(const pg8::f32x4 (&acc)[2][2][4][2], const pg8::Unit& u, int wr, int wc, int fr, int fq) const {
        { int l_ = lane_id(); asm volatile("" : "+v"(l_)); fr = l_ & 15; fq = l_ >> 4; }
        const int pn = u.pn, row0 = u.pm * 256 + wr * 64 + fr, cw = wc * 32 + 8 * fq;
        if (pn == 0) {
            bf16* O = (bf16*)(ws + WS_KVLAT); float* SS = (float*)(ws + WS_SSQKV);
#pragma unroll
            for (int ai = 0; ai < 2; ++ai)
#pragma unroll
                for (int m = 0; m < 4; ++m) { const int row = row0 + ai * 128 + m * 16; float ss = 0.f;
#pragma unroll
                    for (int bj = 0; bj < 2; ++bj) { const f32x4 a = acc[ai][bj][m][0], b = acc[ai][bj][m][1]; *(v4u*)(O + (size_t)row * KVL + bj * 128 + cw) = PACK8(a, b); ss += dot4(a) + dot4(b); }
                    ss += __shfl_xor(ss, 16); ss += __shfl_xor(ss, 32); if (fq == 0) SS[(size_t)row * 4 + wc] = ss; }
        } else if (pn == 1) {
            bf16* O = (bf16*)(ws + WS_QLAT); float* SS = (float*)(ws + WS_SSQQ);
#pragma unroll
            for (int ai = 0; ai < 2; ++ai)
#pragma unroll
                for (int m = 0; m < 4; ++m) { const int row = row0 + ai * 128 + m * 16; float ss = 0.f;
#pragma unroll
                    for (int bj = 0; bj < 2; ++bj) { const f32x4 a = acc[ai][bj][m][0], b = acc[ai][bj][m][1]; *(v4u*)(O + (size_t)row * QL + bj * 128 + cw) = PACK8(a, b); ss += dot4(a) + dot4(b); }
                    ss += __shfl_xor(ss, 16); ss += __shfl_xor(ss, 32); if (fq == 0) SS[(size_t)row * 8 + wc] = ss; }
        } else if (pn == 2) {
            const bool lat = u.pm < 64;
            if (lat) {
                bf16* O = (bf16*)(ws + WS_QLAT); float* SS = (float*)(ws + WS_SSQQ);
#pragma unroll
                for (int ai = 0; ai < 2; ++ai)
#pragma unroll
                    for (int m = 0; m < 4; ++m) { const int row = row0 + ai * 128 + m * 16;
                        const f32x4 a = acc[ai][0][m][0], b = acc[ai][0][m][1]; *(v4u*)(O + (size_t)row * QL + 256 + cw) = PACK8(a, b); float ss = dot4(a) + dot4(b);
                        ss += __shfl_xor(ss, 16); ss += __shfl_xor(ss, 32); if (fq == 0) SS[(size_t)row * 8 + 4 + wc] = ss; }
            }
            if (wc == 0) {
                bf16* KBp = (bf16*)(ws + WS_KB);
#pragma unroll
                for (int ai = 0; ai < 2; ++ai)
#pragma unroll
                    for (int m = 0; m < 4; ++m) { const int row = row0 + ai * 128 + m * 16; f32x4 a = acc[ai][1][m][0], b = acc[ai][1][m][1]; int bb, tk; kv_row(row, bb, tk);
                        if (lat) { const f32x4* rp = (const f32x4*)((const float*)(ws + WS_ROPE) + ((size_t)(row & 2047) * 16 + 4 * fq) * 2); const f32x4 r0 = rp[0], r1 = rp[1];
                            a = (f32x4){a[0] * r0[0] - a[1] * r0[1], a[0] * r0[1] + a[1] * r0[0], a[2] * r0[2] - a[3] * r0[3], a[2] * r0[3] + a[3] * r0[2]};
                            b = (f32x4){b[0] * r1[0] - b[1] * r1[1], b[0] * r1[1] + b[1] * r1[0], b[2] * r1[2] - b[3] * r1[3], b[2] * r1[3] + b[3] * r1[2]}; }
                        const v4u w = PACK8(a, b);
#pragma unroll
                        for (int h = 0; h < NH; ++h) *(v4u*)(KBp + ((size_t)(bb * NH + h) * TK + tk) * DQK + DN + 8 * fq) = w; }
            }
        } else if (pn < 7) {
            bf16* O = (bf16*)(ws + WS_S) + 128 * (pn - 3) + cw;
#pragma unroll
            for (int ai = 0; ai < 2; ++ai)
#pragma unroll
                for (int m = 0; m < 4; ++m) { const int row = row0 + ai * 128 + m * 16; const f32x4 a = acc[ai][0][m][0] * acc[ai][1][m][0], b = acc[ai][0][m][1] * acc[ai][1][m][1]; *(v4u*)(O + (size_t)row * CD) = PACK8(a, b); }
        } else if (pn < 9) {
            bf16* O = (bf16*)(ws + WS_BG) + 256 * (pn - 7) + cw;
#pragma unroll
            for (int ai = 0; ai < 2; ++ai)
#pragma unroll
                for (int m = 0; m < 4; ++m) { const int row = row0 + ai * 128 + m * 16;
#pragma unroll
                    for (int bj = 0; bj < 2; ++bj) { const f32x4 a = acc[ai][bj][m][0], b = acc[ai][bj][m][1]; *(v4u*)(O + (size_t)row * CD + bj * 128) = PACK8(a, b); } }
        } else {
            const size_t co = 128 * (pn - 9) + cw; bf16* OR = (bf16*)(ws + WS_RAT) + co; bf16* OG = (bf16*)(ws + WS_GC) + co;
#pragma unroll
            for (int ai = 0; ai < 2; ++ai)
#pragma unroll
                for (int m = 0; m < 4; ++m) { const int row = row0 + ai * 128 + m * 16; f32x4 ra[2], gc[2];
#pragma unroll
                    for (int n = 0; n < 2; ++n)
#pragma unroll
                        for (int j = 0; j < 4; ++j) { const float xa = fminf(fmaxf(acc[ai][0][m][n][j], -30.f), 30.f), xb = fminf(fmaxf(acc[ai][1][m][n][j], -30.f), 30.f);
                            const float ea = ex2(-1.4426950408889634f * xa), eb = ex2(-1.4426950408889634f * xb); gc[n][j] = rcp(1.f + eb); ra[n][j] = (1.f + eb) * rcp(1.f + ea); }
                    *(v4u*)(OR + (size_t)row * D) = PACK8(ra[0], ra[1]); *(v4u*)(OG + (size_t)row * D) = PACK8(gc[0], gc[1]); }
        }
    }
};
__device__ __forceinline__ float rsq(float x) { return __builtin_amdgcn_rsqf(x); }
__device__ __forceinline__ void rope4(f32x4& a, const f32x4 r) { a = (f32x4){a[0] * r[0] - a[1] * r[1], a[0] * r[1] + a[1] * r[0], a[2] * r[2] - a[3] * r[3], a[2] * r[3] + a[3] * r[2]}; }
struct EpiQ : pg8::EpiBase {
    static constexpr bool PERM = true;
    unsigned char* ws; unsigned char* dob;
    __device__ __forceinline__ void operator()(const pg8::f32x4 (&acc)[2][2][4][2], const pg8::Unit& u, int wr, int wc, int fr, int fq) const {
        { int l_ = lane_id(); asm volatile("" : "+v"(l_)); fr = l_ & 15; fq = l_ >> 4; }
        const int row0 = u.pm * 256 + wr * 64 + fr; const float* SS = (const float*)(ws + WS_SSQQ); const float* RP = (const float*)(ws + WS_ROPE); bf16* QBp = (bf16*)(dob + DO_QB);
        int hh[2], dd[2];
#pragma unroll
        for (int bj = 0; bj < 2; ++bj) { const int n = u.pn * 256 + bj * 128 + wc * 32 + 8 * fq; hh[bj] = n / DQK; dd[bj] = n - hh[bj] * DQK; }
#pragma unroll
        for (int ai = 0; ai < 2; ++ai)
#pragma unroll
            for (int m = 0; m < 4; ++m) { const int row = row0 + ai * 128 + m * 16, b = row >> 11, t = row & 2047;
                const f32x4 s0 = *(const f32x4*)(SS + (size_t)row * 8), s1 = *(const f32x4*)(SS + (size_t)row * 8 + 4);
                const float rs = rsq(((s0[0] + s0[1]) + (s0[2] + s0[3]) + (s1[0] + s1[1]) + (s1[2] + s1[3])) * (1.f / QL) + EPS) * QSCALE;
#pragma unroll
                for (int bj = 0; bj < 2; ++bj) { f32x4 a = acc[ai][bj][m][0] * rs, c = acc[ai][bj][m][1] * rs;
                    if (dd[bj] >= DN) { const f32x4* rp = (const f32x4*)(RP + ((size_t)t * 16 + ((dd[bj] - DN) >> 1)) * 2); rope4(a, rp[0]); rope4(c, rp[1]); }
                    *(v4u*)(QBp + ((size_t)(b * NH + hh[bj]) * T + t) * DQK + dd[bj]) = PACK8(a, c); } }
    }
};
struct EpiKV : pg8::EpiBase {
    static constexpr bool PERM = true;
    unsigned char* ws; unsigned char* dob;
    __device__ __forceinline__ void operator()(const pg8::f32x4 (&acc)[2][2][4][2], const pg8::Unit& u, int wr, int wc, int fr, int fq) const {
        { int l_ = lane_id(); asm volatile("" : "+v"(l_)); fr = l_ & 15; fq = l_ >> 4; }
        const int row0 = u.pm * 256 + wr * 64 + fr; const float* SS = (const float*)(ws + WS_SSQKV); bf16* KBp = (bf16*)(ws + WS_KB); bf16* VBp = (bf16*)(dob + DO_VB);
#pragma unroll
        for (int ai = 0; ai < 2; ++ai)
#pragma unroll
            for (int m = 0; m < 4; ++m) { const int row = row0 + ai * 128 + m * 16; int b, tk; kv_row(row, b, tk);
                const f32x4 s0 = *(const f32x4*)(SS + (size_t)row * 4); const float rs = rsq(((s0[0] + s0[1]) + (s0[2] + s0[3])) * (1.f / KVL) + EPS);
#pragma unroll
                for (int bj = 0; bj < 2; ++bj) { const int n = u.pn * 256 + bj * 128 + wc * 32 + 8 * fq, h = n >> 7, e = n & 127;
                    const f32x4 a = acc[ai][bj][m][0] * rs, c = acc[ai][bj][m][1] * rs; const v4u w = PACK8(a, c);
                    if (e < DN) *(v4u*)(KBp + ((size_t)(b * NH + h) * TK + tk) * DQK + e) = w; else *(v4u*)(VBp + ((size_t)(b * NH + h) * TK + tk) * DV + (e - DN)) = w; } }
    }
};
__device__ __forceinline__ void unpack8(const v4u w, float (&f)[8]) { f[0] = bf2f(w.x & 0xffff); f[1] = bf2f(w.x >> 16); f[2] = bf2f(w.y & 0xffff); f[3] = bf2f(w.y >> 16); f[4] = bf2f(w.z & 0xffff); f[5] = bf2f(w.z >> 16); f[6] = bf2f(w.w & 0xffff); f[7] = bf2f(w.w >> 16); }
__device__ __forceinline__ void p3_conv(const Args& a, int tid, int vcu, int G) {
    unsigned char* ws = a.ws; const bf16* S = (const bf16*)(ws + WS_S); const bf16* BG = (const bf16*)(ws + WS_BG); bf16* AC = (bf16*)(ws + WS_ACAT);
    const float* cw = a.in[I_CW]; const float* cb = a.in[I_CB];
    for (int it = vcu * NWAVES * 64 + tid; it < (M / 8) * (CD / 8); it += G * NWAVES * 64) {
        const int cg = it & 63, run = it >> 6, r0 = run * 8, c0 = cg * 8;
        float w0[8], w1[8], w2[8], bb[8];
#pragma unroll
        for (int i = 0; i < 8; ++i) { w0[i] = cw[c0 + i]; w1[i] = cw[CD + c0 + i]; w2[i] = cw[2 * CD + c0 + i]; bb[i] = cb[c0 + i]; }
        float p[8], c[8], n[8];
        const int t0 = r0 & 2047;
        if (t0 > 0) unpack8(*(const v4u*)(S + (size_t)(r0 - 1) * CD + c0), p); else {
#pragma unroll
            for (int i = 0; i < 8; ++i) p[i] = 0.f; }
        unpack8(*(const v4u*)(S + (size_t)r0 * CD + c0), c);
#pragma unroll
        for (int r = 0; r < 8; ++r) { const int row = r0 + r;
            if ((row & 2047) < T - 1) unpack8(*(const v4u*)(S + (size_t)(row + 1) * CD + c0), n); else {
#pragma unroll
                for (int i = 0; i < 8; ++i) n[i] = 0.f; }
            float g[8], y[8]; unpack8(*(const v4u*)(BG + (size_t)row * CD + c0), g);
#pragma unroll
            for (int i = 0; i < 8; ++i) y[i] = g[i] * (bb[i] + w0[i] * p[i] + w1[i] * c[i] + w2[i] * n[i]);
            *(v4u*)(AC + (size_t)row * D + CD + c0) = (v4u){pg8::cvt_pk_bf16(y[0], y[1]), pg8::cvt_pk_bf16(y[2], y[3]), pg8::cvt_pk_bf16(y[4], y[5]), pg8::cvt_pk_bf16(y[6], y[7])};
#pragma unroll
            for (int i = 0; i < 8; ++i) { p[i] = c[i]; c[i] = n[i]; } }
    }
}
#define EPI_LANES() { int l_ = lane_id(); asm volatile("" : "+v"(l_)); fr = l_ & 15; fq = l_ >> 4; }
struct EpiP5 : pg8::EpiBase {
    static constexpr bool PERM = true, HAS_MID = true;
    unsigned char* ws;
    __device__ __forceinline__ int mid_t() const { return 8; }
    __device__ __forceinline__ void mid(pg8::f32x4 (&acc)[2][2][4][2], const pg8::Unit& u, int wr, int wc, int fr, int fq) const {
        EPI_LANES();
        const bf16* R = (const bf16*)(ws + WS_RAT) + (size_t)(u.pm * 256 + wr * 64 + fr) * D + u.pn * 256 + wc * 32 + 8 * fq;
#pragma unroll
        for (int ai = 0; ai < 2; ++ai) {
#pragma unroll
            for (int m = 0; m < 4; ++m)
#pragma unroll
                for (int bj = 0; bj < 2; ++bj) { float f[8]; unpack8(*(const v4u*)(R + (size_t)(ai * 128 + m * 16) * D + bj * 128), f);
                    acc[ai][bj][m][0] *= (f32x4){f[0], f[1], f[2], f[3]}; acc[ai][bj][m][1] *= (f32x4){f[4], f[5], f[6], f[7]}; }
            asm volatile("" ::: "memory");
        }
    }
    __device__ __forceinline__ void operator()(const pg8::f32x4 (&acc)[2][2][4][2], const pg8::Unit& u, int wr, int wc, int fr, int fq) const {
        EPI_LANES();
        const size_t off = (size_t)(u.pm * 256 + wr * 64 + fr) * D + u.pn * 256 + wc * 32 + 8 * fq;
        const bf16* Gp = (const bf16*)(ws + WS_GC) + off; bf16* O = (bf16*)(ws + WS_MERGED) + off;
#pragma unroll
        for (int ai = 0; ai < 2; ++ai)
#pragma unroll
            for (int m = 0; m < 4; ++m)
#pragma unroll
                for (int bj = 0; bj < 2; ++bj) { const size_t o2 = (size_t)(ai * 128 + m * 16) * D + bj * 128; float f[8]; unpack8(*(const v4u*)(Gp + o2), f);
                    const f32x4 a = acc[ai][bj][m][0] * (f32x4){f[0], f[1], f[2], f[3]}, c = acc[ai][bj][m][1] * (f32x4){f[4], f[5], f[6], f[7]}; *(v4u*)(O + o2) = PACK8(a, c); }
    }
};
struct EpiP6 : pg8::EpiBase {
    static constexpr bool PERM = true;
    unsigned char* ws; const float* x; const float* n2g; float* out;
    __device__ __forceinline__ void operator()(const pg8::f32x4 (&acc)[2][2][4][2], const pg8::Unit& u, int wr, int wc, int fr, int fq) const {
        EPI_LANES();
        const int row0 = u.pm * 256 + wr * 64 + fr, col0 = u.pn * 256 + wc * 32 + 8 * fq, b = (u.pm * 256) >> 11;
        const float* MOD = (const float*)(ws + WS_MOD) + b * MODW; float* SS = (float*)(ws + WS_SSQ2); bf16* A2 = (bf16*)(ws + WS_A2);
        f32x4 g1[2][2], cs[2][2];
#pragma unroll
        for (int bj = 0; bj < 2; ++bj)
#pragma unroll
            for (int n = 0; n < 2; ++n) { const int c = col0 + bj * 128 + 4 * n; g1[bj][n] = *(const f32x4*)(MOD + 2 * D + c); cs[bj][n] = *(const f32x4*)(n2g + c) * (*(const f32x4*)(MOD + 4 * D + c) + 1.f); }
#pragma unroll
        for (int ai = 0; ai < 2; ++ai)
#pragma unroll
            for (int m = 0; m < 4; ++m) { const int row = row0 + ai * 128 + m * 16; float ss = 0.f;
#pragma unroll
                for (int bj = 0; bj < 2; ++bj) { const size_t off = (size_t)row * D + col0 + bj * 128;
                    const f32x4 x0 = *(const f32x4*)(x + off), x1v = *(const f32x4*)(x + off + 4);
                    const f32x4 a = x0 + g1[bj][0] * acc[ai][bj][m][0], c = x1v + g1[bj][1] * acc[ai][bj][m][1];
                    *(f32x4*)(out + off) = a; *(f32x4*)(out + off + 4) = c; ss += dot4(a) + dot4(c);
                    const f32x4 a2 = a * cs[bj][0], c2 = c * cs[bj][1]; *(v4u*)(A2 + off) = PACK8(a2, c2); }
                ss += __shfl_xor(ss, 16); ss += __shfl_xor(ss, 32); if (fq == 0) SS[(size_t)row * 16 + u.pn * 4 + wc] = ss; }
    }
};
struct EpiP9 : pg8::EpiBase {
    static constexpr bool PERM = true;
    unsigned char* ws; float* out;
    __device__ __forceinline__ void operator()(const pg8::f32x4 (&acc)[2][2][4][2], const pg8::Unit& u, int wr, int wc, int fr, int fq) const {
        EPI_LANES();
        const int row0 = u.pm * 256 + wr * 64 + fr, col0 = u.pn * 256 + wc * 32 + 8 * fq, b = (u.pm * 256) >> 11;
        const float* MOD = (const float*)(ws + WS_MOD) + b * MODW; float* SS = (float*)(ws + WS_SSQ3);
        f32x4 g2[2][2];
#pragma unroll
        for (int bj = 0; bj < 2; ++bj)
#pragma unroll
            for (int n = 0; n < 2; ++n) g2[bj][n] = *(const f32x4*)(MOD + 5 * D + col0 + bj * 128 + 4 * n);
#pragma unroll
        for (int ai = 0; ai < 2; ++ai)
#pragma unroll
            for (int m = 0; m < 4; ++m) { const int row = row0 + ai * 128 + m * 16; float ss = 0.f;
#pragma unroll
                for (int bj = 0; bj < 2; ++bj) { const size_t off = (size_t)row * D + col0 + bj * 128;
                    const f32x4 x0 = *(const f32x4*)(out + off), x1v = *(const f32x4*)(out + off + 4);
                    const f32x4 a = x0 + g2[bj][0] * acc[ai][bj][m][0], c = x1v + g2[bj][1] * acc[ai][bj][m][1];
                    *(f32x4*)(out + off) = a; *(f32x4*)(out + off + 4) = c; ss += dot4(a) + dot4(c); }
                ss += __shfl_xor(ss, 16); ss += __shfl_xor(ss, 32); if (fq == 0) SS[(size_t)row * 16 + u.pn * 4 + wc] = ss; }
    }
};
__device__ __forceinline__ void p10_body(const Args& a, int lane, int wave, int vcu, int G) {
    const float* SS = (const float*)(a.ws + WS_SSQ3); const f32x4* g4 = (const f32x4*)a.in[I_FG] + lane;
    f32x4 g[4];
#pragma unroll
    for (int j = 0; j < 4; ++j) g[j] = g4[64 * j];
    for (int row = vcu * NWAVES + wave; row < M; row += G * NWAVES) {
        const f32x4* s4 = (const f32x4*)(SS + (size_t)row * 16); const f32x4 s0 = s4[0], s1 = s4[1], s2 = s4[2], s3 = s4[3];
        const float ss = ((s0[0] + s0[1]) + (s0[2] + s0[3])) + ((s1[0] + s1[1]) + (s1[2] + s1[3])) + ((s2[0] + s2[1]) + (s2[2] + s2[3])) + ((s3[0] + s3[1]) + (s3[2] + s3[3]));
        const float rs = 1.f / sqrtf(ss * (1.f / D) + EPS);
        f32x4* o4 = (f32x4*)(a.out + (size_t)row * D) + lane;
#pragma unroll
        for (int j = 0; j < 4; ++j) o4[64 * j] = o4[64 * j] * rs * g[j];
    }
}
__device__ __forceinline__ float dpp_prev(float old, float v) { return __builtin_bit_cast(float, __builtin_amdgcn_update_dpp(__builtin_bit_cast(int, old), __builtin_bit_cast(int, v), 0x111, 0xf, 0xf, false)); }
__device__ __forceinline__ float dpp_next(float old, float v) { return __builtin_bit_cast(float, __builtin_amdgcn_update_dpp(__builtin_bit_cast(int, old), __builtin_bit_cast(int, v), 0x101, 0xf, 0xf, false)); }
__device__ __forceinline__ float dpp_ror1(float v) { return __builtin_bit_cast(float, __builtin_amdgcn_update_dpp(0, __builtin_bit_cast(int, v), 0x121, 0xf, 0xf, false)); }
__device__ __forceinline__ float dpp_ror15(float v) { return __builtin_bit_cast(float, __builtin_amdgcn_update_dpp(0, __builtin_bit_cast(int, v), 0x12F, 0xf, 0xf, false)); }
constexpr int EX_OFF = LDSCTL_OFF + 1024;
struct EpiP7 : pg8::EpiBase {
    static constexpr bool PERM = true;
    unsigned char* ws; LAS unsigned char* ex;
    __device__ __forceinline__ void operator()(pg8::f32x4 (&acc)[2][2][4][2], const pg8::Unit& u, int wr, int wc, int fr, int fq) const {
        EPI_LANES();
        const int row0 = u.pm * 256 + wr * 64 + fr, b = (u.pm * 256) >> 11, cl = wc * 32 + 8 * fq, nb = u.pn * 256 + cl;
        { const float* SS = (const float*)(ws + WS_SSQ2); const float* SHW = (const float*)(ws + WS_SHW) + b * NUP + nb;
          f32x4 sh[2][2];
#pragma unroll
          for (int bj = 0; bj < 2; ++bj)
#pragma unroll
              for (int n = 0; n < 2; ++n) sh[bj][n] = *(const f32x4*)(SHW + bj * 128 + 4 * n);
#pragma unroll
          for (int ai = 0; ai < 2; ++ai)
#pragma unroll
              for (int m = 0; m < 4; ++m) { const f32x4 s0 = *(const f32x4*)(SS + (size_t)(row0 + ai * 128 + m * 16) * 16 + 4 * fq);
                  float ss = (s0[0] + s0[1]) + (s0[2] + s0[3]); ss += __shfl_xor(ss, 16); ss += __shfl_xor(ss, 32);
                  const float rs = rsq(ss * (1.f / D) + EPS);
#pragma unroll
                  for (int bj = 0; bj < 2; ++bj)
#pragma unroll
                      for (int n = 0; n < 2; ++n) acc[ai][bj][m][n] = acc[ai][bj][m][n] * rs + sh[bj][n];
                  if (m & 1) asm volatile("" ::: "memory"); } }
        { float* HALO = (float*)(ws + WS_HALO) + (size_t)u.pm * 4 * NUP + nb;
          if (wr == 0) { if (fr < 2) {
#pragma unroll
              for (int bj = 0; bj < 2; ++bj)
#pragma unroll
                  for (int n = 0; n < 2; ++n) *(f32x4*)(HALO + (size_t)fr * NUP + bj * 128 + 4 * n) = acc[0][bj][0][n]; } }
          else { if (fr >= 14) {
#pragma unroll
              for (int bj = 0; bj < 2; ++bj)
#pragma unroll
                  for (int n = 0; n < 2; ++n) *(f32x4*)(HALO + (size_t)(fr - 12) * NUP + bj * 128 + 4 * n) = acc[1][bj][3][n]; } }
          LAS f32x4* EX = (LAS f32x4*)ex;
#pragma unroll
          for (int ai = 0; ai < 2; ++ai) { const int k = 2 * ai + wr;
              if (fr == 0) {
#pragma unroll
                  for (int bj = 0; bj < 2; ++bj)
#pragma unroll
                      for (int n = 0; n < 2; ++n) EX[((k * 2 + 0) * 256 + bj * 128 + cl + 4 * n) >> 2] = acc[ai][bj][0][n]; }
              if (fr == 15) {
#pragma unroll
                  for (int bj = 0; bj < 2; ++bj)
#pragma unroll
                      for (int n = 0; n < 2; ++n) EX[((k * 2 + 1) * 256 + bj * 128 + cl + 4 * n) >> 2] = acc[ai][bj][3][n]; } }
          asm volatile("s_waitcnt lgkmcnt(0)" ::: "memory"); __builtin_amdgcn_s_barrier(); asm volatile("" ::: "memory"); }
        const float* FCW = (const float*)(ws + WS_FCW) + nb; const float* FCB = (const float*)(ws + WS_FCB) + nb;
        bf16* ACTp = (bf16*)(ws + WS_ACT) + (size_t)row0 * FF + u.pn * 128 + cl;
        const LAS f32x4* EXr = (const LAS f32x4*)ex;
#pragma unroll
        for (int ai = 0; ai < 2; ++ai) { const int k = 2 * ai + wr;
            v2u pk0[4];
#pragma unroll
            for (int n = 0; n < 2; ++n) {
                f32x4 cg[4];
#pragma unroll
                for (int bj = 0; bj < 2; ++bj) {
                    const int co = bj * 128 + 4 * n;
                    const f32x4 w0 = *(const f32x4*)(FCW + co), w1 = *(const f32x4*)(FCW + NUP + co), w2 = *(const f32x4*)(FCW + 2 * NUP + co), bb = *(const f32x4*)(FCB + co);
                    f32x4 exp_ = (f32x4){0.f, 0.f, 0.f, 0.f}, exn_ = (f32x4){0.f, 0.f, 0.f, 0.f};
                    if (k > 0) exp_ = EXr[(((k - 1) * 2 + 1) * 256 + cl + co) >> 2];
                    if (k < 3) exn_ = EXr[(((k + 1) * 2 + 0) * 256 + cl + co) >> 2];
#pragma unroll
                    for (int m = 0; m < 4; ++m) { f32x4 r;
#pragma unroll
                        for (int j = 0; j < 4; ++j) { const float c = acc[ai][bj][m][n][j];
                            const float po = (m > 0) ? dpp_ror1(acc[ai][bj][m > 0 ? m - 1 : 0][n][j]) : exp_[j];
                            const float no = (m < 3) ? dpp_ror15(acc[ai][bj][m < 3 ? m + 1 : 3][n][j]) : exn_[j];
                            const float pv = dpp_prev(po, c), nv = dpp_next(no, c);
                            r[j] = bb[j] + w0[j] * pv + w1[j] * c + w2[j] * nv; }
                        if (bj == 0) cg[m] = r;
                        else { f32x4 o;
#pragma unroll
                            for (int j = 0; j < 4; ++j) { const float g = cg[m][j]; o[j] = g * rcp(1.f + ex2(-1.4426950408889634f * g)) * r[j]; }
                            const v2u pk = (v2u){pg8::cvt_pk_bf16(o[0], o[1]), pg8::cvt_pk_bf16(o[2], o[3])};
                            if (n == 0) pk0[m] = pk; else *(v4u*)(ACTp + (size_t)(ai * 128 + m * 16) * FF) = (v4u){pk0[m].x, pk0[m].y, pk.x, pk.y}; } }
                    asm volatile("" ::: "memory");
                }
            }
        }
    }
};
__device__ __forceinline__ void p9_fixup(const Args& a, int pm, int tid) {
    const float* HALO = (const float*)(a.ws + WS_HALO); const float* FCW = (const float*)(a.ws + WS_FCW); const float* FCB = (const float*)(a.ws + WS_FCB); bf16* ACTp = (bf16*)(a.ws + WS_ACT);
    const int sub = pm & 7;
    for (int it = tid; it < 2 * (FF / 8); it += NWAVES * 64) {
        const int sel = it / (FF / 8), g = it % (FF / 8);
        if ((sel == 0 && sub == 0) || (sel == 1 && sub == 7)) continue;
        const int ch = g * 8, ng = (ch >> 7) * 256 + (ch & 127);
        const float* hp; const float* hc; const float* hn; int row;
        if (sel == 0) { hp = HALO + ((size_t)(pm - 1) * 4 + 3) * NUP; hc = HALO + ((size_t)pm * 4 + 0) * NUP; hn = HALO + ((size_t)pm * 4 + 1) * NUP; row = pm * 256; }
        else { hp = HALO + ((size_t)pm * 4 + 2) * NUP; hc = HALO + ((size_t)pm * 4 + 3) * NUP; hn = HALO + ((size_t)(pm + 1) * 4 + 0) * NUP; row = pm * 256 + 255; }
        f32x4 o[2];
#pragma unroll
        for (int hf = 0; hf < 2; ++hf) { f32x4 cc[2];
#pragma unroll
            for (int bj = 0; bj < 2; ++bj) { const int n = ng + bj * 128 + 4 * hf;
                cc[bj] = *(const f32x4*)(FCB + n) + *(const f32x4*)(FCW + n) * *(const f32x4*)(hp + n) + *(const f32x4*)(FCW + NUP + n) * *(const f32x4*)(hc + n) + *(const f32x4*)(FCW + 2 * NUP + n) * *(const f32x4*)(hn + n); }
#pragma unroll
            for (int j = 0; j < 4; ++j) { const float gq = cc[0][j]; o[hf][j] = gq * rcp(1.f + ex2(-1.4426950408889634f * gq)) * cc[1][j]; } }
        *(v4u*)(ACTp + (size_t)row * FF + ch) = PACK8(o[0], o[1]);
    }
}
namespace att {
using f32x16 = float __attribute__((ext_vector_type(16)));
using s16x4 = short __attribute__((ext_vector_type(4)));
constexpr int KROW = 208;
constexpr int SHM_K = 64 * KROW, SHM_V = 64 * DV * 2;
constexpr int OFF_V = 0, OFF_K = 2 * SHM_V, OFF_WS = OFF_K + 2 * SHM_K, OFF_OST = OFF_WS + 8 * 64 * 4, LDS_ATT = OFF_OST + 8 * 4096;
constexpr float THRL = 8.f;
#define ATT_SBAR() __builtin_amdgcn_sched_barrier(0)
__device__ __forceinline__ int crow(int r, int hi) { return (r & 3) + 8 * (r >> 2) + 4 * hi; }
__device__ __forceinline__ unsigned cvtpk(float lo, float hi) { unsigned r; asm volatile("v_cvt_pk_bf16_f32 %0, %1, %2" : "=v"(r) : "v"(lo), "v"(hi)); return r; }
__device__ __forceinline__ void partialSM(f32x16& p0, f32x16& p1, float& m_reg, float& alpha) {
    float pmax = p0[0];
#pragma unroll
    for (int r = 1; r < 16; ++r) pmax = fmaxf(pmax, p0[r]);
#pragma unroll
    for (int r = 0; r < 16; ++r) pmax = fmaxf(pmax, p1[r]);
    { auto rr = __builtin_amdgcn_permlane32_swap(__float_as_uint(pmax), __float_as_uint(pmax), false, false); pmax = fmaxf(__uint_as_float(rr[0]), __uint_as_float(rr[1])); }
    float mn;
    if (__builtin_expect(__all(pmax - m_reg <= THRL), 1)) { mn = m_reg; alpha = 1.f; }
    else { mn = fmaxf(m_reg, pmax); alpha = __builtin_amdgcn_exp2f(m_reg - mn); m_reg = mn; }
#pragma unroll
    for (int r = 0; r < 16; ++r) p0[r] = p0[r] - mn;
#pragma unroll
    for (int r = 0; r < 16; ++r) p1[r] = p1[r] - mn;
#pragma unroll
    for (int r = 0; r < 16; ++r) p0[r] = __builtin_amdgcn_exp2f(p0[r]);
}
__device__ __forceinline__ void finishSM(f32x16& p0, f32x16& p1, float alpha, float& l_reg, bf16x8& pa0, bf16x8& pa1, bf16x8& pa2, bf16x8& pa3) {
#pragma unroll
    for (int r = 0; r < 16; ++r) p1[r] = __builtin_amdgcn_exp2f(p1[r]);
    float ps = 0.f;
#pragma unroll
    for (int r = 0; r < 16; ++r) ps += p0[r];
#pragma unroll
    for (int r = 0; r < 16; ++r) ps += p1[r];
    { auto rr = __builtin_amdgcn_permlane32_swap(__float_as_uint(ps), __float_as_uint(ps), false, false); ps = __uint_as_float(rr[0]) + __uint_as_float(rr[1]); }
    l_reg = l_reg * alpha + ps;
#define ATT_PK4(P, BASE, OUT) do { unsigned a0 = cvtpk(P[BASE + 0], P[BASE + 1]), a1 = cvtpk(P[BASE + 2], P[BASE + 3]);   \
    unsigned b0 = cvtpk(P[BASE + 4], P[BASE + 5]), b1 = cvtpk(P[BASE + 6], P[BASE + 7]);                              \
    auto r0 = __builtin_amdgcn_permlane32_swap(a0, b0, false, false); auto r1 = __builtin_amdgcn_permlane32_swap(a1, b1, false, false); \
    v4u w = {r0[0], r1[0], r0[1], r1[1]}; OUT = __builtin_bit_cast(bf16x8, w); } while (0)
    ATT_PK4(p0, 0, pa0); ATT_PK4(p0, 8, pa1); ATT_PK4(p1, 0, pa2); ATT_PK4(p1, 8, pa3);
#undef ATT_PK4
}
__device__ __forceinline__ void qkt(f32x16& p0, f32x16& p1, const LAS unsigned char* Ks, const bf16x8* qr, int r32, int hi) {
    p0 = f32x16{}; p1 = f32x16{};
#pragma unroll
    for (int d0 = 0; d0 < 6; ++d0) { const int cb = (d0 * 16 + hi * 8) * 2;
        const bf16x8 b0 = *(const LAS bf16x8*)(Ks + r32 * KROW + cb);
        const bf16x8 b1 = *(const LAS bf16x8*)(Ks + (32 + r32) * KROW + cb);
        p0 = __builtin_amdgcn_mfma_f32_32x32x16_bf16(b0, qr[d0], p0, 0, 0, 0);
        p1 = __builtin_amdgcn_mfma_f32_32x32x16_bf16(b1, qr[d0], p1, 0, 0, 0); }
}
__device__ __forceinline__ int v_st(int k, int c) { const int kk = (k & ~0xC) | ((k & 4) << 1) | ((k & 8) >> 1); return ((kk >> 3) * 2 + (c >> 5)) * 512 + ((kk & 7) * 32 + (c & 31)) * 2; }
__device__ __forceinline__ int v_rd_base(int lane) { return ((lane & 3) << 3) | (((lane >> 2) & 3) << 6) | (((lane >> 4) & 1) << 5) | (((lane >> 5) & 1) << 8); }
constexpr int v_rd_off(int d0, int ks, int half) { return d0 * 512 + ks * 2048 + half * 1024; }
template <int OFF> __device__ __forceinline__ s16x4 tr_read(int vb) { s16x4 r; asm volatile("ds_read_b64_tr_b16 %0, %1 offset:%2" : "=&v"(r) : "v"(vb), "i"(OFF) : "memory"); return r; }
template <int D0> __device__ __forceinline__ void pv_one(f32x16& od, int vb, bf16x8 pa0, bf16x8 pa1, bf16x8 pa2, bf16x8 pa3) {
    const s16x4 l0 = tr_read<v_rd_off(D0, 0, 0)>(vb), h0 = tr_read<v_rd_off(D0, 0, 1)>(vb), l1 = tr_read<v_rd_off(D0, 1, 0)>(vb), h1 = tr_read<v_rd_off(D0, 1, 1)>(vb);
    const s16x4 l2 = tr_read<v_rd_off(D0, 2, 0)>(vb), h2 = tr_read<v_rd_off(D0, 2, 1)>(vb), l3 = tr_read<v_rd_off(D0, 3, 0)>(vb), h3 = tr_read<v_rd_off(D0, 3, 1)>(vb);
    asm volatile("s_waitcnt lgkmcnt(0)" ::: "memory"); ATT_SBAR();
#define ATT_PK(L, H) (bf16x8){L[0], L[1], L[2], L[3], H[0], H[1], H[2], H[3]}
    od = __builtin_amdgcn_mfma_f32_32x32x16_bf16(pa0, ATT_PK(l0, h0), od, 0, 0, 0);
    od = __builtin_amdgcn_mfma_f32_32x32x16_bf16(pa1, ATT_PK(l1, h1), od, 0, 0, 0);
    od = __builtin_amdgcn_mfma_f32_32x32x16_bf16(pa2, ATT_PK(l2, h2), od, 0, 0, 0);
    od = __builtin_amdgcn_mfma_f32_32x32x16_bf16(pa3, ATT_PK(l3, h3), od, 0, 0, 0);
#undef ATT_PK
}
__device__ __forceinline__ void pv_d0(f32x16* o, int vb, bf16x8 pa0, bf16x8 pa1, bf16x8 pa2, bf16x8 pa3) { pv_one<0>(o[0], vb, pa0, pa1, pa2, pa3); pv_one<1>(o[1], vb, pa0, pa1, pa2, pa3); }

__device__ __forceinline__ void attn_unit(const bf16* __restrict__ Qb, const bf16* __restrict__ Kh, const bf16* __restrict__ Vh, bf16* __restrict__ Ob, int ldo, LAS unsigned char* lds, int wid) {
    int lane = lane_id(); asm volatile("" : "+v"(lane));
    const int tid = wid * 64 + lane, r32 = lane & 31, hi = lane >> 5;
    LAS unsigned char* V_lds = lds + OFF_V; LAS unsigned char* K_lds = lds + OFF_K;
    LAS float* wsf = (LAS float*)(lds + OFF_WS) + wid * 64; LAS float* li_l = wsf; LAS float* al_l = wsf + 32;
    float m_reg = -1e30f, l_reg = 0.f; f32x16 o[2] = {}; bf16x8 qr[6];
    const bf16* Qw = Qb + (size_t)(wid * 32 + r32) * DQK + hi * 8;
#pragma unroll
    for (int d0 = 0; d0 < 6; ++d0) qr[d0] = *(const bf16x8*)(Qw + d0 * 16);
    const bool two = wid < 4;
    const int kc0 = tid, kc1 = 512 + tid;
    const int kst0 = (kc0 / 12) * KROW + (kc0 % 12) * 16, kst1 = (kc1 / 12) * KROW + (kc1 % 12) * 16;
    const int vst0 = v_st(tid >> 3, (tid & 7) * 8);
    const int vb0 = (int)(uintptr_t)V_lds + v_rd_base(lane);
    struct { bf16x8 k0, k1, v0; } sr_[2];
#define ATT_SLOAD(i, t) do { const bf16* kp = Kh + (size_t)(t) * (64 * DQK); sr_[i].k0 = *(const bf16x8*)(kp + kc0 * 8); if (two) sr_[i].k1 = *(const bf16x8*)(kp + kc1 * 8); \
    sr_[i].v0 = *(const bf16x8*)(Vh + (size_t)(t) * (64 * DV) + tid * 8); } while (0)
#define ATT_SWRITE(b, i) do { *(LAS bf16x8*)(K_lds + (b) * SHM_K + kst0) = sr_[i].k0; if (two) *(LAS bf16x8*)(K_lds + (b) * SHM_K + kst1) = sr_[i].k1; \
    *(LAS bf16x8*)(V_lds + (b) * SHM_V + vst0) = sr_[i].v0; } while (0)
#define ATT_SWAIT() do { if (two) asm volatile("s_waitcnt vmcnt(3)" ::: "memory"); else asm volatile("s_waitcnt vmcnt(2)" ::: "memory"); } while (0)
#define ATT_RESC(a) do { if (__any((a) < 1.f)) { if (hi == 0) al_l[r32] = (a); asm volatile("s_waitcnt lgkmcnt(0)" ::: "memory"); \
    _Pragma("unroll") for (int d = 0; d < 2; ++d) _Pragma("unroll") for (int r = 0; r < 16; ++r) o[d][r] *= al_l[crow(r, hi)]; } } while (0)
    f32x16 pA0, pA1, pB0, pB1; float alA, alB; bf16x8 pa0, pa1, pa2, pa3; constexpr int NT = TK / 64;
    ATT_SLOAD(0, 0); asm volatile("s_waitcnt vmcnt(0)" ::: "memory"); ATT_SWRITE(0, 0); __syncthreads();
    qkt(pA0, pA1, K_lds, qr, r32, hi); partialSM(pA0, pA1, m_reg, alA);
    ATT_SLOAD(1, 1); ATT_SLOAD(0, 2);
    ATT_SWAIT(); ATT_SWRITE(1, 1); __syncthreads();
    for (int j = 1; j + 1 < NT; j += 2) {
        ATT_SBAR(); qkt(pB0, pB1, K_lds + SHM_K, qr, r32, hi);
        finishSM(pA0, pA1, alA, l_reg, pa0, pa1, pa2, pa3); ATT_SBAR();
        ATT_SLOAD(1, j + 2); ATT_SBAR();
        pv_d0(o, vb0, pa0, pa1, pa2, pa3); partialSM(pB0, pB1, m_reg, alB);
        __syncthreads(); ATT_SWAIT(); ATT_SWRITE(0, 0);
        ATT_RESC(alB); __syncthreads();
        ATT_SBAR(); qkt(pA0, pA1, K_lds, qr, r32, hi);
        finishSM(pB0, pB1, alB, l_reg, pa0, pa1, pa2, pa3); ATT_SBAR();
        if (j + 3 < NT) ATT_SLOAD(0, j + 3); ATT_SBAR();
        pv_d0(o, vb0 + SHM_V, pa0, pa1, pa2, pa3); partialSM(pA0, pA1, m_reg, alA);
        __syncthreads(); ATT_SWAIT(); ATT_SWRITE(1, 1);
        ATT_RESC(alA); __syncthreads();
    }
    ATT_SBAR(); qkt(pB0, pB1, K_lds + SHM_K, qr, r32, hi);
    finishSM(pA0, pA1, alA, l_reg, pa0, pa1, pa2, pa3); ATT_SBAR();
    pv_d0(o, vb0, pa0, pa1, pa2, pa3); partialSM(pB0, pB1, m_reg, alB);
    __syncthreads(); ATT_RESC(alB);
    finishSM(pB0, pB1, alB, l_reg, pa0, pa1, pa2, pa3); ATT_SBAR();
    pv_d0(o, vb0 + SHM_V, pa0, pa1, pa2, pa3);
    if (hi == 0) li_l[r32] = l_reg; asm volatile("s_waitcnt lgkmcnt(0)" ::: "memory");
    float rli[16];
#pragma unroll
    for (int r = 0; r < 16; ++r) rli[r] = __builtin_amdgcn_rcpf(li_l[crow(r, hi)]);
    LAS bf16* stg = (LAS bf16*)(lds + OFF_OST) + wid * 2048;
#pragma unroll
    for (int r = 0; r < 16; ++r) { const int orow = crow(r, hi);
#pragma unroll
        for (int d0 = 0; d0 < 2; ++d0) stg[orow * 64 + d0 * 32 + r32] = (bf16)f2bf(o[d0][r] * rli[r]); }
    asm volatile("s_waitcnt lgkmcnt(0)" ::: "memory");
    bf16* Ow = Ob + (size_t)(wid * 32) * ldo;
#pragma unroll
    for (int i = 0; i < 4; ++i) { const int row = i * 8 + (lane >> 3), ch = lane & 7; const v4u v = *(const LAS v4u*)(stg + row * 64 + ch * 8); *(v4u*)(Ow + (size_t)row * ldo + ch * 8) = v; }
    __syncthreads();
#undef ATT_SLOAD
#undef ATT_SWRITE
#undef ATT_SWAIT
#undef ATT_RESC
}
__device__ __forceinline__ void attn_phase(const Args& a, LAS unsigned char* lds, int wid, int vcu, int G) {
    const bf16* QBp = (const bf16*)((unsigned char*)a.out + DO_QB); const bf16* KBp = (const bf16*)(a.ws + WS_KB); const bf16* VBp = (const bf16*)((unsigned char*)a.out + DO_VB); bf16* AC = (bf16*)(a.ws + WS_ACAT);
    for (int U = vcu; U < NB * NH * (T / 256); U += G) { const int bh = U >> 3, qb = U & 7, b = bh >> 3, h = bh & 7;
        attn_unit(QBp + ((size_t)bh * T + qb * 256) * DQK, KBp + (size_t)bh * TK * DQK, VBp + (size_t)bh * TK * DV, AC + (size_t)(b * T + qb * 256) * D + h * DV, D, lds, wid); }
}
#undef ATT_SBAR
}

template <class Map>
__device__ __forceinline__ void tr_item(const float* W, int Ns, bf16* WT, int ld, int dk0, const float* kscale, Map map, int nblk, LAS float* scr, int item, int lane) {
    const int kb = item / nblk, nb = item % nblk, k0 = 64 * kb, n0 = 32 * nb;
    const int src = map(n0 + (lane & 31));
#pragma unroll 8
    for (int i = 0; i < 32; ++i) { const int kk = 2 * i + (lane >> 5); float v = 0.f; if (src >= 0) { v = W[(size_t)(k0 + kk) * Ns + src]; if (kscale) v *= kscale[k0 + kk]; } scr[kk * 33 + (lane & 31)] = v; }
    asm volatile("s_waitcnt lgkmcnt(0)" ::: "memory");
    const int c = lane & 7;
#pragma unroll
    for (int j = 0; j < 4; ++j) { const int n = (lane >> 3) + 8 * j; const LAS float* s = scr + (8 * c) * 33 + n;
        v4u o; o.x = pk2(s[0 * 33], s[1 * 33]); o.y = pk2(s[2 * 33], s[3 * 33]); o.z = pk2(s[4 * 33], s[5 * 33]); o.w = pk2(s[6 * 33], s[7 * 33]);
        *(v4u*)(WT + (size_t)(n0 + n) * ld + dk0 + k0 + 8 * c) = o; }
    asm volatile("s_waitcnt lgkmcnt(0)" ::: "memory");
}

__device__ __forceinline__ void p0_body(const Args& a, LAS unsigned char* lds, int tid, int lane, int wave, int vcu, int G) {
    unsigned char* ws = a.ws;
    {
        LAS float* sc = (LAS float*)lds;
        LAS float* red = (LAS float*)(lds + 9 * 1024 * 4);
        float* MOD = (float*)(ws + WS_MOD);
        bool loaded = false;
        for (int u = vcu; u < MODW / 32; u += G) {
            if (!loaded) {
                for (int i = tid; i < 9 * 1024; i += NWAVES * 64) { const int b = i >> 10, k = i & 1023; const float v = b < 8 ? a.in[I_C][b * 1024 + k] : a.in[I_CCTX][k]; sc[i] = silu_f(v); }
                loaded = true;
            }
            __syncthreads();
            const int col = tid & 31, kg = tid >> 5;
            float acc[9];
#pragma unroll
            for (int b = 0; b < 9; ++b) acc[b] = 0.f;
            const float* wp = a.in[I_WADA] + (size_t)u * 32 + col;
#pragma unroll 4
            for (int k = kg; k < 1024; k += 16) { const float w = wp[(size_t)k * MODW];
#pragma unroll
                for (int b = 0; b < 9; ++b) acc[b] += sc[b * 1024 + k] * w; }
#pragma unroll
            for (int b = 0; b < 9; ++b) red[(kg * 9 + b) * 32 + col] = acc[b];
            __syncthreads();
            if (tid < 9 * 32) { const int b = tid >> 5, c2 = tid & 31; float s = 0.f;
#pragma unroll
                for (int g = 0; g < 16; ++g) s += red[(g * 9 + b) * 32 + c2];
                MOD[b * MODW + u * 32 + c2] = s + a.in[I_BADA][u * 32 + c2]; }
            __syncthreads();
        }
        __syncthreads();
    }
    {
        LAS float* scr = (LAS float*)(lds + wave * 16384);
        const int gw = vcu * NWAVES + wave, NGW = G * NWAVES;
        constexpr int I_IN = 16 * (NIN / 32), I_UQ = 6 * 24, I_UKV = 4 * 32, I_AO = 8 * 32, I_CO = 8 * 32, I_O = 16 * 32, I_UP = 16 * (NUP / 32), I_DN = 44 * 32;
        constexpr int NITEMS = I_IN + I_UQ + I_UKV + I_AO + I_CO + I_O + I_UP + I_DN;
        for (int it = gw; it < NITEMS; it += NGW) {
            int r = it;
            if (r < I_IN) { tr_item(a.in[I_WIN], 4256, (bf16*)(ws + WS_WIN), 1024, 0, nullptr, WinMap(), NIN / 32, scr, r, lane); continue; } r -= I_IN;
            if (r < I_UQ) { tr_item(a.in[I_WUQ], 768, (bf16*)(ws + WS_WUQ), 384, 0, a.in[I_QNG], WuqMap(), 24, scr, r, lane); continue; } r -= I_UQ;
            if (r < I_UKV) { tr_item(a.in[I_WUKV], 1024, (bf16*)(ws + WS_WUKV), 256, 0, a.in[I_KVNG], IdMap(), 32, scr, r, lane); continue; } r -= I_UKV;
            if (r < I_AO) { tr_item(a.in[I_WAO], 1024, (bf16*)(ws + WS_WCAT), 1024, 0, nullptr, IdMap(), 32, scr, r, lane); continue; } r -= I_AO;
            if (r < I_CO) { tr_item(a.in[I_WCO], 1024, (bf16*)(ws + WS_WCAT), 1024, 512, nullptr, IdMap(), 32, scr, r, lane); continue; } r -= I_CO;
            if (r < I_O) { tr_item(a.in[I_WO], 1024, (bf16*)(ws + WS_WO), 1024, 0, nullptr, IdMap(), 32, scr, r, lane); continue; } r -= I_O;
            if (r < I_UP) { tr_item(a.in[I_WUP], NUP, (bf16*)(ws + WS_WUP), 1024, 0, nullptr, WupMap(), NUP / 32, scr, r, lane); continue; } r -= I_UP;
            tr_item(a.in[I_WDOWN], 1024, (bf16*)(ws + WS_WDOWN), FF, 0, nullptr, IdMap(), 32, scr, r, lane);
        }
    }
    {
        const int gt = vcu * NWAVES * 64 + tid, NGT = G * NWAVES * 64;
        float* ROPE = (float*)(ws + WS_ROPE);
        for (int i = gt; i < T * 16; i += NGT) { const int t = i >> 4, k = i & 15, ax = k >> 3, f = k & 7;
            const float inv = powf(10000.f, -(float)(2 * f) / 16.f); const float pos = (float)(ax == 0 ? (t >> 6) : (t & 63)); const float ang = pos * inv;
            ROPE[2 * i] = cosf(ang); ROPE[2 * i + 1] = sinf(ang); }
        float* FCW = (float*)(ws + WS_FCW); float* FCB = (float*)(ws + WS_FCB);
        for (int i = gt; i < 3 * NUP; i += NGT) { const int k = i / NUP, n = i % NUP; FCW[i] = a.in[I_FCW][k * NUP + wup_map(n)]; }
        for (int i = gt; i < NUP; i += NGT) FCB[i] = a.in[I_FCB][wup_map(i)];
    }
}

__device__ __forceinline__ void p1_body(const Args& a, int lane, int wave, int vcu, int G) {
    unsigned char* ws = a.ws;
    const float* MOD = (const float*)(ws + WS_MOD);
    bf16* Hb = (bf16*)((unsigned char*)a.out + DO_H);
    const int gw = vcu * NWAVES + wave, NGW = G * NWAVES;
    for (int row = gw; row < MKV; row += NGW) {
        const float* xr; int mb;
        if (row < M) { xr = a.in[I_X] + (size_t)row * D; mb = row >> 11; } else { xr = a.in[I_CTX] + (size_t)(row - M) * D; mb = 8; }
        const f32x4* x4 = (const f32x4*)xr + lane;
        f32x4 v[4]; float s = 0.f;
#pragma unroll
        for (int j = 0; j < 4; ++j) { v[j] = x4[64 * j]; s += (v[j].x * v[j].x + v[j].y * v[j].y) + (v[j].z * v[j].z + v[j].w * v[j].w); }
        const float rstd = 1.f / sqrtf(wave_sum(s) * (1.f / D) + EPS);
        const f32x4* g4 = (const f32x4*)a.in[I_N1G] + lane;
        const f32x4* sh4 = (const f32x4*)(MOD + mb * MODW) + lane;
        const f32x4* sc4 = (const f32x4*)(MOD + mb * MODW + D) + lane;
        unsigned long long* o8 = (unsigned long long*)(Hb + (size_t)row * D) + lane;
#pragma unroll
        for (int j = 0; j < 4; ++j) { const f32x4 g = g4[64 * j], sh = sh4[64 * j], sc = sc4[64 * j];
            const f32x4 y = (v[j] * rstd) * g * (sc + 1.f) + sh;
            o8[64 * j] = (unsigned long long)pk2(y.x, y.y) | ((unsigned long long)pk2(y.z, y.w) << 32); }
    }
    const bf16* WUP = (const bf16*)(ws + WS_WUP); float* SHW = (float*)(ws + WS_SHW);
    for (int n = gw; n < NUP; n += NGW) {
        const v4u* w4 = (const v4u*)(WUP + (size_t)n * D) + 2 * lane;
        const v4u w0 = w4[0], w1 = w4[1];
        float wf[16];
        wf[0] = bf2f(w0.x & 0xffff); wf[1] = bf2f(w0.x >> 16); wf[2] = bf2f(w0.y & 0xffff); wf[3] = bf2f(w0.y >> 16); wf[4] = bf2f(w0.z & 0xffff); wf[5] = bf2f(w0.z >> 16); wf[6] = bf2f(w0.w & 0xffff); wf[7] = bf2f(w0.w >> 16);
        wf[8] = bf2f(w1.x & 0xffff); wf[9] = bf2f(w1.x >> 16); wf[10] = bf2f(w1.y & 0xffff); wf[11] = bf2f(w1.y >> 16); wf[12] = bf2f(w1.z & 0xffff); wf[13] = bf2f(w1.z >> 16); wf[14] = bf2f(w1.w & 0xffff); wf[15] = bf2f(w1.w >> 16);
#pragma unroll
        for (int b = 0; b < 8; ++b) { const f32x4* s4 = (const f32x4*)(MOD + b * MODW + 3 * D) + 4 * lane; float s = 0.f;
#pragma unroll
            for (int q = 0; q < 4; ++q) { const f32x4 sv = s4[q]; s += sv.x * wf[4 * q] + sv.y * wf[4 * q + 1] + sv.z * wf[4 * q + 2] + sv.w * wf[4 * q + 3]; }
            s = wave_sum(s); if (lane == 0) SHW[b * NUP + n] = s; }
    }
}

__global__ void __launch_bounds__(NWAVES * 64, 2) skel_fwd(Args args) {
    extern __shared__ __attribute__((aligned(16))) unsigned char lds_raw[];
    LAS unsigned char* lds = (LAS unsigned char*)lds_raw;
    const int wave = __builtin_amdgcn_readfirstlane(threadIdx.x >> 6);
#define FRESH_TID() int lane = lane_id(); asm volatile("" : "+v"(lane)); const int tid = wave * 64 + lane; (void)tid
#define LEADER() (wave == 0 && lane_id() == 0)
    const int G = gridDim.x; const int bx = blockIdx.x; const int vcu = (G % 8 == 0) ? (bx % 8) * (G / 8) + bx / 8 : bx;
    unsigned char* ws = args.ws;
    volatile LAS unsigned* MISC = (volatile LAS unsigned*)(lds + MISC_OFF);
    for (int u = threadIdx.x; u < (LDS_BYTES - LDSCTL_OFF) / 4; u += NWAVES * 64) ((LAS unsigned*)(lds + LDSCTL_OFF))[u] = 0u;
    __syncthreads();
    const int lo = args.ph_lo, hi = args.ph_hi;
    XcdBarrier bar = xcd_barrier_post((unsigned*)(ws + WS_CTL) + CW_BAR + args.li * XCD_BAR_WORDS, MISC + 8, LEADER());
#define IN(k) (lo <= (k) && (k) < hi)
#define SEAM(k) do { if (IN(k) && ((k) == 7 ? 9 : (k) + 1) < hi) xcd_barrier(bar, LEADER()); } while (0)
    if (IN(0)) { FRESH_TID(); p0_body(args, lds, tid, lane, wave, vcu, G); } SEAM(0);
    if (IN(1)) { FRESH_TID(); p1_body(args, lane, wave, vcu, G); } SEAM(1);
    if (IN(2)) {
        pg8::Gemm g{(const bf16*)((unsigned char*)args.out + DO_H), (const bf16*)(ws + WS_WIN), MKV, NIN, D};
        SchedP2 S; S.init(G, bx);
        EpiP2 E; E.ws = ws;
        pg8::gemm_phase<EpiP2, SchedP2, true, true>(lds + RING_OFF, g, S, E, wave);
    } SEAM(2);
    if (IN(3)) {
        { pg8::Gemm g{(const bf16*)(ws + WS_KVLAT), (const bf16*)(ws + WS_WUKV), MKV, 1024, KVL}; pg8::StaticOrder S; S.init(MKV, 1024, G, bx);
          EpiKV E; E.ws = ws; E.dob = (unsigned char*)args.out;
          pg8::gemm_phase<EpiKV, pg8::StaticOrder, true, true>(lds + RING_OFF, g, S, E, wave); }
        { pg8::Gemm g{(const bf16*)(ws + WS_QLAT), (const bf16*)(ws + WS_WUQ), M, 768, QL}; pg8::StaticOrder S; S.init(M, 768, G, G - 1 - bx);
          EpiQ E; E.ws = ws; E.dob = (unsigned char*)args.out;
          pg8::gemm_phase<EpiQ, pg8::StaticOrder, true, true>(lds + RING_OFF, g, S, E, wave); }
        { FRESH_TID(); p3_conv(args, tid, vcu, G); }
    } SEAM(3);
    if (IN(4)) { att::attn_phase(args, lds + RING_OFF, wave, vcu, G); } SEAM(4);
    if (IN(5)) {
        pg8::Gemm g{(const bf16*)(ws + WS_ACAT), (const bf16*)(ws + WS_WCAT), M, D, D}; pg8::StaticOrder S; S.init(M, D, G, bx);
        EpiP5 E; E.ws = ws;
        pg8::gemm_phase<EpiP5, pg8::StaticOrder, true, true>(lds + RING_OFF, g, S, E, wave);
    } SEAM(5);
    if (IN(6)) {
        pg8::Gemm g{(const bf16*)(ws + WS_MERGED), (const bf16*)(ws + WS_WO), M, D, D}; pg8::StaticOrder S; S.init(M, D, G, bx);
        EpiP6 E; E.ws = ws; E.x = args.in[I_X]; E.n2g = args.in[I_N2G]; E.out = args.out;
        pg8::gemm_phase<EpiP6, pg8::StaticOrder, true, true>(lds + RING_OFF, g, S, E, wave);
    } SEAM(6);
    if (IN(7)) {
        pg8::Gemm g{(const bf16*)(ws + WS_A2), (const bf16*)(ws + WS_WUP), M, NUP, D}; pg8::StaticOrder S; S.init(M, NUP, G, bx);
        EpiP7 E; E.ws = ws; E.ex = lds + EX_OFF;
        pg8::gemm_phase<EpiP7, pg8::StaticOrder, true, true>(lds + RING_OFF, g, S, E, wave);
    } SEAM(7);
    if (IN(9)) {
        pg8::Gemm g{(const bf16*)(ws + WS_ACT), (const bf16*)(ws + WS_WDOWN), M, D, FF}; pg8::StaticOrder S; S.init(M, D, G, bx);
        { pg8::Unit u0; for (int i = 0; S.next(i, u0); ++i) { FRESH_TID(); p9_fixup(args, u0.pm, tid); }
          asm volatile("s_waitcnt vmcnt(0)" ::: "memory"); __syncthreads(); }
        EpiP9 E; E.ws = ws; E.out = args.out;
        pg8::gemm_phase<EpiP9, pg8::StaticOrder, true, true>(lds + RING_OFF, g, S, E, wave);
    } SEAM(9);
    if (IN(10)) { FRESH_TID(); p10_body(args, lane, wave, vcu, G); }
#undef IN
#undef SEAM
}
template <class Epi, int MODE>
__global__ void __launch_bounds__(256) naive_gemm(const bf16* A, int lda, const bf16* Bt, int ldb, int K, int ksplit, Epi epi) {
    __shared__ float As[32][65], Bs[32][65], Bs2[32][65];
    const int tid = threadIdx.x, tx = tid & 15, ty = tid >> 4;
    const int row0 = blockIdx.y * 64, col0 = blockIdx.x * 64;
    if (!epi.active(row0, col0)) return;
    const int poff = (MODE == 1) ? epi.pair_off(col0) : 0;
    float acc[4][4], acc2[4][4];
#pragma unroll
    for (int i = 0; i < 4; ++i)
#pragma unroll
        for (int j = 0; j < 4; ++j) { acc[i][j] = 0.f; acc2[i][j] = 0.f; }
    const int lr = tid >> 2, kc = (tid & 3) * 8;
    for (int k0 = 0; k0 < K; k0 += 32) {
        { const v4u av = *(const v4u*)(A + (size_t)(row0 + lr) * lda + k0 + kc); const v4u bv = *(const v4u*)(Bt + (size_t)(col0 + lr) * ldb + k0 + kc);
          const unsigned aw[4] = {av.x, av.y, av.z, av.w}, bw[4] = {bv.x, bv.y, bv.z, bv.w};
#pragma unroll
          for (int i = 0; i < 4; ++i) { As[kc + 2 * i][lr] = bf2f(aw[i] & 0xffff); As[kc + 2 * i + 1][lr] = bf2f(aw[i] >> 16); Bs[kc + 2 * i][lr] = bf2f(bw[i] & 0xffff); Bs[kc + 2 * i + 1][lr] = bf2f(bw[i] >> 16); }
          if (MODE == 1) { const v4u cv = *(const v4u*)(Bt + (size_t)(col0 + poff + lr) * ldb + k0 + kc); const unsigned cw[4] = {cv.x, cv.y, cv.z, cv.w};
#pragma unroll
              for (int i = 0; i < 4; ++i) { Bs2[kc + 2 * i][lr] = bf2f(cw[i] & 0xffff); Bs2[kc + 2 * i + 1][lr] = bf2f(cw[i] >> 16); } } }
        __syncthreads();
        const bool second = (MODE == 2) && (k0 >= ksplit);
#pragma unroll 8
        for (int kk = 0; kk < 32; ++kk) {
            float av[4], bv[4], cv[4];
#pragma unroll
            for (int i = 0; i < 4; ++i) { av[i] = As[kk][ty * 4 + i]; bv[i] = Bs[kk][tx * 4 + i]; cv[i] = (MODE == 1) ? Bs2[kk][tx * 4 + i] : 0.f; }
            if (MODE == 2 && second) {
#pragma unroll
                for (int i = 0; i < 4; ++i)
#pragma unroll
                    for (int j = 0; j < 4; ++j) acc2[i][j] += av[i] * bv[j];
            } else {
#pragma unroll
                for (int i = 0; i < 4; ++i)
#pragma unroll
                    for (int j = 0; j < 4; ++j) { acc[i][j] += av[i] * bv[j]; if (MODE == 1) acc2[i][j] += av[i] * cv[j]; }
            }
        }
        __syncthreads();
    }
#pragma unroll
    for (int i = 0; i < 4; ++i) epi(row0 + ty * 4 + i, col0 + tx * 4, acc[i], acc2[i]);
}

struct EpiN2 {
    unsigned char* ws;
    __device__ __forceinline__ bool active(int row0, int col0) const { const int pn = col0 >> 8, r = col0 & 255;
        if (row0 >= M && !(pn == 0 || pn == 2)) return false;
        if (pn == 2 && r >= 192) return false;
        if (((pn >= 3 && pn < 7) || pn >= 9) && r >= 128) return false;
        return true; }
    __device__ __forceinline__ int pair_off(int col0) const { const int pn = col0 >> 8; return ((pn >= 3 && pn < 7) || pn >= 9) ? 128 : 0; }
    __device__ __forceinline__ void operator()(int row, int n, const float* v, const float* v2) const {
        const int pn = n >> 8, r = n & 255;
        if (pn == 0) { bf16* o = (bf16*)(ws + WS_KVLAT) + (size_t)row * KVL + r; *(v2u*)o = (v2u){pk2(v[0], v[1]), pk2(v[2], v[3])}; return; }
        if (pn == 1 || (pn == 2 && r < 128)) { if (row >= M) return; bf16* o = (bf16*)(ws + WS_QLAT) + (size_t)row * QL + (pn == 1 ? r : 256 + r); *(v2u*)o = (v2u){pk2(v[0], v[1]), pk2(v[2], v[3])}; return; }
        if (pn == 2) { if (r >= 160) return; const int jj = r - 128; int b, tk; kv_row(row, b, tk); float o0 = v[0], o1 = v[1], o2 = v[2], o3 = v[3];
            if (row < M) { const float* rp = (const float*)(ws + WS_ROPE) + ((size_t)(row & 2047) * 16 + (jj >> 1)) * 2; const float c0 = rp[0], s0 = rp[1], c1 = rp[2], s1 = rp[3];
                o0 = v[0] * c0 - v[1] * s0; o1 = v[0] * s0 + v[1] * c0; o2 = v[2] * c1 - v[3] * s1; o3 = v[2] * s1 + v[3] * c1; }
            const v2u w = (v2u){pk2(o0, o1), pk2(o2, o3)};
            for (int h = 0; h < NH; ++h) *(v2u*)((bf16*)(ws + WS_KB) + ((size_t)(b * NH + h) * TK + tk) * DQK + DN + jj) = w;
            return; }
        if (pn < 7) { bf16* o = (bf16*)(ws + WS_S) + (size_t)row * CD + 128 * (pn - 3) + r; *(v2u*)o = (v2u){pk2(v[0] * v2[0], v[1] * v2[1]), pk2(v[2] * v2[2], v[3] * v2[3])}; return; }
        if (pn < 9) { bf16* o = (bf16*)(ws + WS_BG) + (size_t)row * CD + (n - 7 * 256); *(v2u*)o = (v2u){pk2(v[0], v[1]), pk2(v[2], v[3])}; return; }
        { const size_t off = (size_t)row * D + 128 * (pn - 9) + r; float ra[4], gc[4];
#pragma unroll
          for (int i = 0; i < 4; ++i) { const float ga = sigm_f(v[i]); gc[i] = sigm_f(v2[i]); ra[i] = ga / gc[i]; }
          *(v2u*)((bf16*)(ws + WS_RAT) + off) = (v2u){pk2(ra[0], ra[1]), pk2(ra[2], ra[3])}; *(v2u*)((bf16*)(ws + WS_GC) + off) = (v2u){pk2(gc[0], gc[1]), pk2(gc[2], gc[3])}; }
    }
};
__global__ void __launch_bounds__(256) naive_ssq_bf16(const bf16* src, int ncols, int nrows, float* out, int np) {
    const int row = blockIdx.x * 4 + (threadIdx.x >> 6), lane = threadIdx.x & 63; if (row >= nrows) return;
    float s = 0.f; for (int c = lane; c < ncols; c += 64) { const float v = bf2f(src[(size_t)row * ncols + c]); s += v * v; }
    s = wave_sum(s); if (lane < np) out[(size_t)row * np + lane] = lane == 0 ? s : 0.f;
}
__global__ void __launch_bounds__(256) naive_ssq_f32(const float* src, int ncols, int nrows, float* out, int np) {
    const int row = blockIdx.x * 4 + (threadIdx.x >> 6), lane = threadIdx.x & 63; if (row >= nrows) return;
    float s = 0.f; for (int c = lane; c < ncols; c += 64) { const float v = src[(size_t)row * ncols + c]; s += v * v; }
    s = wave_sum(s); if (lane < np) out[(size_t)row * np + lane] = lane == 0 ? s : 0.f;
}
struct EpiN3Q {
    unsigned char* ws; unsigned char* dob;
    __device__ __forceinline__ bool active(int, int) const { return true; }
    __device__ __forceinline__ int pair_off(int) const { return 0; }
    __device__ __forceinline__ void operator()(int row, int n, const float* v, const float*) const {
        const float* sp = (const float*)(ws + WS_SSQQ) + (size_t)row * 8; float ss = 0.f;
#pragma unroll
        for (int i = 0; i < 8; ++i) ss += sp[i];
        const float rs = 1.f / sqrtf(ss * (1.f / QL) + EPS) * QSCALE;
        const int h = n / DQK, d = n % DQK, b = row >> 11, t = row & 2047;
        float o0 = v[0] * rs, o1 = v[1] * rs, o2 = v[2] * rs, o3 = v[3] * rs;
        if (d >= DN) { const int jj = d - DN; const float* rp = (const float*)(ws + WS_ROPE) + ((size_t)t * 16 + (jj >> 1)) * 2; const float c0 = rp[0], s0 = rp[1], c1 = rp[2], s1 = rp[3];
            const float a0 = o0, a1 = o1, a2 = o2, a3 = o3; o0 = a0 * c0 - a1 * s0; o1 = a0 * s0 + a1 * c0; o2 = a2 * c1 - a3 * s1; o3 = a2 * s1 + a3 * c1; }
        *(v2u*)((bf16*)(dob + DO_QB) + ((size_t)(b * NH + h) * T + t) * DQK + d) = (v2u){pk2(o0, o1), pk2(o2, o3)};
    }
};
struct EpiN3KV {
    unsigned char* ws; unsigned char* dob;
    __device__ __forceinline__ bool active(int, int) const { return true; }
    __device__ __forceinline__ int pair_off(int) const { return 0; }
    __device__ __forceinline__ void operator()(int row, int n, const float* v, const float*) const {
        const float* sp = (const float*)(ws + WS_SSQKV) + (size_t)row * 4; const float ss = (sp[0] + sp[1]) + (sp[2] + sp[3]);
        const float rs = 1.f / sqrtf(ss * (1.f / KVL) + EPS);
        const int h = n >> 7, e = n & 127; int b, tk; kv_row(row, b, tk);
        const v2u w = (v2u){pk2(v[0] * rs, v[1] * rs), pk2(v[2] * rs, v[3] * rs)};
        if (e < DN) *(v2u*)((bf16*)(ws + WS_KB) + ((size_t)(b * NH + h) * TK + tk) * DQK + e) = w;
        else *(v2u*)((bf16*)(dob + DO_VB) + ((size_t)(b * NH + h) * TK + tk) * DV + (e - DN)) = w;
    }
};
__global__ void __launch_bounds__(256) naive_conv(const float* cw, const float* cb, unsigned char* ws) {
    const size_t i = (size_t)blockIdx.x * 256 + threadIdx.x; if (i >= (size_t)M * CD) return;
    const int row = (int)(i / CD), ch = (int)(i % CD), t = row & 2047;
    const bf16* S = (const bf16*)(ws + WS_S); const bf16* BG = (const bf16*)(ws + WS_BG);
    float y = cb[ch] + cw[CD + ch] * bf2f(S[i]);
    if (t > 0) y += cw[ch] * bf2f(S[i - CD]);
    if (t < T - 1) y += cw[2 * CD + ch] * bf2f(S[i + CD]);
    ((bf16*)(ws + WS_ACAT))[(size_t)row * D + CD + ch] = (bf16)f2bf(bf2f(BG[i]) * y);
}
__global__ void __launch_bounds__(256) naive_attn(unsigned char* ws, unsigned char* dob) {
    __shared__ float Ks[64][97]; __shared__ float Vs[64][65];
    const int bh = blockIdx.y, qb = blockIdx.x, b = bh >> 3, h = bh & 7, tid = threadIdx.x, q = tid >> 2, part = tid & 3;
    const bf16* QB = (const bf16*)(dob + DO_QB) + ((size_t)bh * T + qb * 64 + q) * DQK + part * 24;
    const bf16* KB = (const bf16*)(ws + WS_KB) + (size_t)bh * TK * DQK;
    const bf16* VB = (const bf16*)(dob + DO_VB) + (size_t)bh * TK * DV;
    float qv[24];
#pragma unroll
    for (int i = 0; i < 24; ++i) qv[i] = bf2f(QB[i]);
    float m = -1e30f, l = 0.f, o[16];
#pragma unroll
    for (int i = 0; i < 16; ++i) o[i] = 0.f;
    for (int tile = 0; tile < TK / 64; ++tile) {
        { const int r = tid >> 2, c0 = (tid & 3) * 24; const bf16* kp = KB + ((size_t)tile * 64 + r) * DQK + c0;
#pragma unroll
          for (int i = 0; i < 24; ++i) Ks[r][c0 + i] = bf2f(kp[i]);
          const int c1 = (tid & 3) * 16; const bf16* vp = VB + ((size_t)tile * 64 + r) * DV + c1;
#pragma unroll
          for (int i = 0; i < 16; ++i) Vs[r][c1 + i] = bf2f(vp[i]); }
        __syncthreads();
        for (int k = 0; k < 64; ++k) {
            float s = 0.f;
#pragma unroll
            for (int i = 0; i < 24; ++i) s += qv[i] * Ks[k][part * 24 + i];
            s += __shfl_xor(s, 1); s += __shfl_xor(s, 2);
            const float mn = fmaxf(m, s), alpha = exp2f(m - mn), p = exp2f(s - mn);
            l = l * alpha + p;
#pragma unroll
            for (int i = 0; i < 16; ++i) o[i] = o[i] * alpha + p * Vs[k][part * 16 + i];
            m = mn;
        }
        __syncthreads();
    }
    const float rl = 1.f / l;
    bf16* op = (bf16*)(ws + WS_ACAT) + ((size_t)(b * T + qb * 64 + q)) * D + h * DV + part * 16;
#pragma unroll
    for (int i = 0; i < 16; ++i) op[i] = (bf16)f2bf(o[i] * rl);
}
struct EpiN5 {
    unsigned char* ws;
    __device__ __forceinline__ bool active(int, int) const { return true; }
    __device__ __forceinline__ int pair_off(int) const { return 0; }
    __device__ __forceinline__ void operator()(int row, int n, const float* v, const float* v2) const {
        const size_t off = (size_t)row * D + n; const bf16* ra = (const bf16*)(ws + WS_RAT) + off; const bf16* gc = (const bf16*)(ws + WS_GC) + off; float o[4];
#pragma unroll
        for (int i = 0; i < 4; ++i) o[i] = bf2f(gc[i]) * (bf2f(ra[i]) * v[i] + v2[i]);
        *(v2u*)((bf16*)(ws + WS_MERGED) + off) = (v2u){pk2(o[0], o[1]), pk2(o[2], o[3])};
    }
};
struct EpiN6 {
    unsigned char* ws; const float* x; const float* n2g; float* out;
    __device__ __forceinline__ bool active(int, int) const { return true; }
    __device__ __forceinline__ int pair_off(int) const { return 0; }
    __device__ __forceinline__ void operator()(int row, int n, const float* v, const float*) const {
        const int b = row >> 11; const float* MOD = (const float*)(ws + WS_MOD) + b * MODW; const size_t off = (size_t)row * D + n; float x1[4], a2[4];
#pragma unroll
        for (int i = 0; i < 4; ++i) { x1[i] = x[off + i] + MOD[2 * D + n + i] * v[i]; a2[i] = x1[i] * n2g[n + i] * (1.f + MOD[4 * D + n + i]); }
        *(f32x4*)(out + off) = (f32x4){x1[0], x1[1], x1[2], x1[3]};
        *(v2u*)((bf16*)(ws + WS_A2) + off) = (v2u){pk2(a2[0], a2[1]), pk2(a2[2], a2[3])};
    }
};
__global__ void __launch_bounds__(256) naive_p7(unsigned char* ws) {
    __shared__ float As[32][69], Bs[32][65], Bs2[32][65];
    const int tid = threadIdx.x, tx = tid & 15, ty = tid >> 4;
    const int r0 = blockIdx.y * 64, bx = blockIdx.x, pn = bx >> 1, nb = pn * 256 + (bx & 1) * 64;
    const int ch0 = bx * 64;
    const bf16* A = (const bf16*)(ws + WS_A2); const bf16* Bt = (const bf16*)(ws + WS_WUP);
    float acc[6][4], acc2[6][4];
#pragma unroll
    for (int i = 0; i < 6; ++i)
#pragma unroll
        for (int j = 0; j < 4; ++j) { acc[i][j] = 0.f; acc2[i][j] = 0.f; }
    for (int k0 = 0; k0 < D; k0 += 32) {
        for (int c = tid; c < 66 * 4; c += 256) { const int lr = c >> 2, kc = (c & 3) * 8; int gr = r0 - 1 + lr; gr = gr < 0 ? 0 : (gr > M - 1 ? M - 1 : gr);
            const v4u av = *(const v4u*)(A + (size_t)gr * D + k0 + kc); const unsigned aw[4] = {av.x, av.y, av.z, av.w};
#pragma unroll
            for (int i = 0; i < 4; ++i) { As[kc + 2 * i][lr] = bf2f(aw[i] & 0xffff); As[kc + 2 * i + 1][lr] = bf2f(aw[i] >> 16); } }
        { const int lr = tid >> 2, kc = (tid & 3) * 8;
          const v4u bv = *(const v4u*)(Bt + (size_t)(nb + lr) * D + k0 + kc); const v4u cv = *(const v4u*)(Bt + (size_t)(nb + 128 + lr) * D + k0 + kc);
          const unsigned bw[4] = {bv.x, bv.y, bv.z, bv.w}, cw[4] = {cv.x, cv.y, cv.z, cv.w};
#pragma unroll
          for (int i = 0; i < 4; ++i) { Bs[kc + 2 * i][lr] = bf2f(bw[i] & 0xffff); Bs[kc + 2 * i + 1][lr] = bf2f(bw[i] >> 16); Bs2[kc + 2 * i][lr] = bf2f(cw[i] & 0xffff); Bs2[kc + 2 * i + 1][lr] = bf2f(cw[i] >> 16); } }
        __syncthreads();
#pragma unroll 4
        for (int kk = 0; kk < 32; ++kk) {
            float av[6], bv[4], cv[4];
#pragma unroll
            for (int i = 0; i < 6; ++i) av[i] = As[kk][ty * 4 + i];
#pragma unroll
            for (int j = 0; j < 4; ++j) { bv[j] = Bs[kk][tx * 4 + j]; cv[j] = Bs2[kk][tx * 4 + j]; }
#pragma unroll
            for (int i = 0; i < 6; ++i)
#pragma unroll
                for (int j = 0; j < 4; ++j) { acc[i][j] += av[i] * bv[j]; acc2[i][j] += av[i] * cv[j]; }
        }
        __syncthreads();
    }
    const float* SSQ2 = (const float*)(ws + WS_SSQ2); const float* SHW = (const float*)(ws + WS_SHW); const float* FCW = (const float*)(ws + WS_FCW); const float* FCB = (const float*)(ws + WS_FCB);
    float* HALO = (float*)(ws + WS_HALO);
    const int ng = nb + tx * 4, nv = ng + 128;
    float ug[6][4], uv[6][4];
#pragma unroll
    for (int i = 0; i < 6; ++i) { int gr = r0 + ty * 4 - 1 + i; gr = gr < 0 ? 0 : (gr > M - 1 ? M - 1 : gr); const int b = gr >> 11;
        float ss = 0.f;
#pragma unroll
        for (int q = 0; q < 16; ++q) ss += SSQ2[(size_t)gr * 16 + q];
        const float rs = 1.f / sqrtf(ss * (1.f / D) + EPS);
#pragma unroll
        for (int j = 0; j < 4; ++j) { ug[i][j] = rs * acc[i][j] + SHW[b * NUP + ng + j]; uv[i][j] = rs * acc2[i][j] + SHW[b * NUP + nv + j]; } }
#pragma unroll
    for (int i = 1; i < 5; ++i) { const int gr = r0 + ty * 4 - 1 + i, t = gr & 2047; float o[4];
#pragma unroll
        for (int j = 0; j < 4; ++j) {
            float cg = FCB[ng + j] + FCW[NUP + ng + j] * ug[i][j], cv = FCB[nv + j] + FCW[NUP + nv + j] * uv[i][j];
            if (t > 0) { cg += FCW[ng + j] * ug[i - 1][j]; cv += FCW[nv + j] * uv[i - 1][j]; }
            if (t < T - 1) { cg += FCW[2 * NUP + ng + j] * ug[i + 1][j]; cv += FCW[2 * NUP + nv + j] * uv[i + 1][j]; }
            o[j] = silu_f(cg) * cv; }
        *(v2u*)((bf16*)(ws + WS_ACT) + (size_t)gr * FF + ch0 + tx * 4) = (v2u){pk2(o[0], o[1]), pk2(o[2], o[3])};
        const int rr = gr & 255; const int hi = rr == 0 ? 0 : rr == 1 ? 1 : rr == 254 ? 2 : rr == 255 ? 3 : -1;
        if (hi >= 0) { float* hp = HALO + ((size_t)(gr >> 8) * 4 + hi) * NUP;
#pragma unroll
            for (int j = 0; j < 4; ++j) { hp[ng + j] = ug[i][j]; hp[nv + j] = uv[i][j]; } }
    }
}
struct EpiN9 {
    unsigned char* ws; float* out;
    __device__ __forceinline__ bool active(int, int) const { return true; }
    __device__ __forceinline__ int pair_off(int) const { return 0; }
    __device__ __forceinline__ void operator()(int row, int n, const float* v, const float*) const {
        const int b = row >> 11; const float* MOD = (const float*)(ws + WS_MOD) + b * MODW; const size_t off = (size_t)row * D + n; f32x4 x1 = *(const f32x4*)(out + off);
        x1.x += MOD[5 * D + n] * v[0]; x1.y += MOD[5 * D + n + 1] * v[1]; x1.z += MOD[5 * D + n + 2] * v[2]; x1.w += MOD[5 * D + n + 3] * v[3];
        *(f32x4*)(out + off) = x1;
    }
};
__global__ void __launch_bounds__(256) naive_final(float* out, const float* ssq3, const float* fg) {
    const int row = blockIdx.x * 4 + (threadIdx.x >> 6), lane = threadIdx.x & 63;
    float ss = 0.f;
#pragma unroll
    for (int q = 0; q < 16; ++q) ss += ssq3[(size_t)row * 16 + q];
    const float rs = 1.f / sqrtf(ss * (1.f / D) + EPS);
    f32x4* o4 = (f32x4*)(out + (size_t)row * D) + lane; const f32x4* g4 = (const f32x4*)fg + lane;
#pragma unroll
    for (int j = 0; j < 4; ++j) o4[64 * j] = o4[64 * j] * rs * g4[64 * j];
}

#ifndef OPT_MASK
#define OPT_MASK 0x7ffu
#endif
#ifndef FUSE
#define FUSE 1
#endif
extern "C" void kernel_launch(void* const* d_in, const int* in_sizes, int n_in, void* d_out, int out_size, void* d_ws, size_t ws_size, hipStream_t stream) {
    static int grid = 0;
    if (grid == 0) {
        if (n_in != 23 || in_sizes[0] != M * D || out_size != M * D || ws_size < WS_END) { fprintf(stderr, "kernel_launch: unexpected shapes (n_in %d, in0 %d, out %d, ws %zu)\n", n_in, n_in > 0 ? in_sizes[0] : -1, out_size, ws_size); grid = -1; return; }
        int dev = 0, cus = 0, per_cu = 0;
        if (hipGetDevice(&dev) != hipSuccess || hipDeviceGetAttribute(&cus, hipDeviceAttributeMultiprocessorCount, dev) != hipSuccess) { grid = -1; return; }
        if (hipFuncSetAttribute((const void*)skel_fwd, hipFuncAttributeMaxDynamicSharedMemorySize, LDS_BYTES) != hipSuccess) { fprintf(stderr, "kernel_launch: hipFuncSetAttribute failed\n"); grid = -1; return; }
        if (hipOccupancyMaxActiveBlocksPerMultiprocessor(&per_cu, (const void*)skel_fwd, NWAVES * 64, LDS_BYTES) != hipSuccess || per_cu < 1) { fprintf(stderr, "kernel_launch: occupancy query says %d\n", per_cu); per_cu = 1; }
        (void)hipGetLastError();
        grid = cus * 1;
    }
    if (grid < 0) return;
    unsigned char* ws = (unsigned char*)d_ws; unsigned char* dob = (unsigned char*)d_out;
    (void)hipMemsetAsync(ws + WS_CTL, 0, CTL_ZERO_BYTES, stream);
    Args a{};
    for (int i = 0; i < 23; ++i) a.in[i] = (const float*)d_in[i];
    a.out = (float*)d_out; a.ws = ws;
    const float* const* in = (const float* const*)d_in;
    int li = 0;
#define SKEL(lo_, hi_) do { a.ph_lo = (lo_); a.ph_hi = (hi_); a.li = li++; hipLaunchKernelGGL(skel_fwd, dim3(grid), dim3(NWAVES * 64), LDS_BYTES, stream, a); } while (0)
    for (int p = 0; p <= 10;) {
        if (OPT_MASK & (1u << p)) { int q = p + 1; if (FUSE) while (q <= 10 && (OPT_MASK & (1u << q))) ++q; SKEL(p, q); p = q; continue; }
        switch (p) {
        case 2:
            hipLaunchKernelGGL((naive_gemm<EpiN2, 1>), dim3(NIN / 64, MKV / 64), dim3(256), 0, stream, (const bf16*)(dob + DO_H), D, (const bf16*)(ws + WS_WIN), D, D, 0, EpiN2{ws});
            hipLaunchKernelGGL(naive_ssq_bf16, dim3(MKV / 4), dim3(256), 0, stream, (const bf16*)(ws + WS_KVLAT), KVL, MKV, (float*)(ws + WS_SSQKV), 4);
            hipLaunchKernelGGL(naive_ssq_bf16, dim3(M / 4), dim3(256), 0, stream, (const bf16*)(ws + WS_QLAT), QL, M, (float*)(ws + WS_SSQQ), 8);
            break;
        case 3:
            hipLaunchKernelGGL((naive_gemm<EpiN3Q, 0>), dim3(768 / 64, M / 64), dim3(256), 0, stream, (const bf16*)(ws + WS_QLAT), QL, (const bf16*)(ws + WS_WUQ), QL, QL, 0, EpiN3Q{ws, dob});
            hipLaunchKernelGGL((naive_gemm<EpiN3KV, 0>), dim3(1024 / 64, MKV / 64), dim3(256), 0, stream, (const bf16*)(ws + WS_KVLAT), KVL, (const bf16*)(ws + WS_WUKV), KVL, KVL, 0, EpiN3KV{ws, dob});
            hipLaunchKernelGGL(naive_conv, dim3((M * CD) / 256), dim3(256), 0, stream, in[I_CW], in[I_CB], ws);
            break;
        case 4: hipLaunchKernelGGL(naive_attn, dim3(T / 64, NB * NH), dim3(256), 0, stream, ws, dob); break;
        case 5: hipLaunchKernelGGL((naive_gemm<EpiN5, 2>), dim3(D / 64, M / 64), dim3(256), 0, stream, (const bf16*)(ws + WS_ACAT), D, (const bf16*)(ws + WS_WCAT), D, D, 512, EpiN5{ws}); break;
        case 6:
            hipLaunchKernelGGL((naive_gemm<EpiN6, 0>), dim3(D / 64, M / 64), dim3(256), 0, stream, (const bf16*)(ws + WS_MERGED), D, (const bf16*)(ws + WS_WO), D, D, 0, EpiN6{ws, in[I_X], in[I_N2G], (float*)d_out});
            hipLaunchKernelGGL(naive_ssq_f32, dim3(M / 4), dim3(256), 0, stream, (const float*)d_out, D, M, (float*)(ws + WS_SSQ2), 16);
            break;
        case 7: hipLaunchKernelGGL(naive_p7, dim3(FF / 64, M / 64), dim3(256), 0, stream, ws); break;
        case 9:
            hipLaunchKernelGGL((naive_gemm<EpiN9, 0>), dim3(D / 64, M / 64), dim3(256), 0, stream, (const bf16*)(ws + WS_ACT), FF, (const bf16*)(ws + WS_WDOWN), FF, FF, 0, EpiN9{ws, (float*)d_out});
            hipLaunchKernelGGL(naive_ssq_f32, dim3(M / 4), dim3(256), 0, stream, (const float*)d_out, D, M, (float*)(ws + WS_SSQ3), 16);
            break;
        case 10: hipLaunchKernelGGL(naive_final, dim3(M / 4), dim3(256), 0, stream, (float*)d_out, (const float*)(ws + WS_SSQ3), in[I_FG]); break;
        default: break;
        }
        ++p;
    }
#undef SKEL
}
```
